# Optimizing an MI355X kernel written in HIP

```python
import jax
import jax.numpy as jnp
from jax import lax

D_MODEL = 1024
BATCH = 2
SEQ = 8192
DEPTH = 2

RWKV_HEAD_DIM = 64
RWKV_WIDTH = D_MODEL // 2
RWKV_HEADS = RWKV_WIDTH // RWKV_HEAD_DIM
DECAY_LORA = 64
AAA_LORA = 64
MV_LORA = 32
GATE_LORA = 128
LRU_WIDTH = D_MODEL // 2
LRU_BLOCKS = 8
LRU_BLOCK_DIM = LRU_WIDTH // LRU_BLOCKS
CONV_WIDTH = 4
LRU_C = 8.0
D_FF = 2816
N_NORMS = 6
RMS_EPS = 1e-6
GN_EPS = 64e-5
W_SHIFT = 3 * RWKV_WIDTH + DECAY_LORA + AAA_LORA + GATE_LORA
W_IN = W_SHIFT + 2 * LRU_WIDTH + 2 * D_MODEL

kernel_name = "hybrid_rwkv7_rglru_macaron_block"


def _rmsnorm(x, g):
    x32 = x.astype(jnp.float32)
    y = x32 * lax.rsqrt(jnp.mean(x32 * x32, axis=-1, keepdims=True) + RMS_EPS)
    return (y * g.astype(jnp.float32)).astype(x.dtype)


def _swiglu(h, w_up, w_down):
    gate, up = jnp.split(h @ w_up, 2, axis=-1)
    return (jax.nn.silu(gate) * up) @ w_down


def _token_shift(p):
    return jnp.pad(p[:, :-1], ((0, 0), (1, 0), (0, 0)))


def _heads(t):
    return t.reshape(t.shape[0], t.shape[1], RWKV_HEADS, RWKV_HEAD_DIM)


def _rwkv7_scan(r, w, k, v, a, b):
    bsz = r.shape[0]
    xs = tuple(jnp.moveaxis(t, 1, 0) for t in (r, w, k, v, a, b))

    def step(S, inp):
        r_t, w_t, k_t, v_t, a_t, b_t = inp
        sa = jnp.einsum("bhvk,bhk->bhv", S, a_t)
        S = (S * w_t[:, :, None, :] + sa[..., :, None] * b_t[..., None, :]
             + v_t[..., :, None] * k_t[..., None, :])
        return S, jnp.einsum("bhvk,bhk->bhv", S, r_t)

    S0 = jnp.zeros((bsz, RWKV_HEADS, RWKV_HEAD_DIM, RWKV_HEAD_DIM), jnp.float32)
    _, y = lax.scan(step, S0, xs)
    return jnp.moveaxis(y, 0, 1)


def _group_norm(y, gain, bias):
    mu = jnp.mean(y, axis=-1, keepdims=True)
    var = jnp.mean(jnp.square(y - mu), axis=-1, keepdims=True)
    yn = (y - mu) * lax.rsqrt(var + GN_EPS)
    return yn.reshape(y.shape[0], y.shape[1], RWKV_WIDTH) * gain + bias


def _rwkv7_branch(p, v_first, v_mix, w0, w_up, a0, a_up, g_up, k_k, k_a, r_k, ln_w, ln_b):
    p = p.astype(jnp.float32)
    r, k, v, xw, xa, xg = jnp.split(
        p, [RWKV_WIDTH, 2 * RWKV_WIDTH, 3 * RWKV_WIDTH, 3 * RWKV_WIDTH + DECAY_LORA,
            3 * RWKV_WIDTH + DECAY_LORA + AAA_LORA], axis=-1)
    w = -jax.nn.softplus(-(w0 + jnp.tanh(xw) @ w_up)) - 0.5
    if v_first is None:
        v_first = v
    else:
        v0, v_down, v_upm = v_mix
        v = v + (v_first - v) * jax.nn.sigmoid(v0 + (v @ v_down) @ v_upm)
    a = jax.nn.sigmoid(a0 + xa @ a_up)
    g = jax.nn.sigmoid(xg) @ g_up
    kk = _heads(k * k_k)
    kk = kk / jnp.maximum(jnp.sqrt(jnp.sum(kk * kk, axis=-1, keepdims=True)), 1e-12)
    k = k * (1.0 + (a - 1.0) * k_a)
    rh, kh, vh = _heads(r), _heads(k), _heads(v)
    y = _rwkv7_scan(rh, _heads(jnp.exp(-jnp.exp(w))), kh, vh, -kk, kk * _heads(a))
    bonus = jnp.sum(rh * kh * r_k.reshape(RWKV_HEADS, RWKV_HEAD_DIM), axis=-1, keepdims=True) * vh
    y = _group_norm(y, ln_w, ln_b) + bonus.reshape(y.shape[0], y.shape[1], RWKV_WIDTH)
    return y * g, v_first


def _rglru_branch(xb, gate_in, conv_w, conv_b, lru_wa, lru_ba, lru_wx, lru_bx, lru_lambda):
    bsz, seq = xb.shape[0], xb.shape[1]
    xb = lax.conv_general_dilated(
        xb, conv_w[:, None, :], window_strides=(1,), padding=[(CONV_WIDTH - 1, 0)],
        dimension_numbers=("NWC", "WIO", "NWC"), feature_group_count=LRU_WIDTH) + conv_b
    blocks = xb.reshape(bsz, seq, LRU_BLOCKS, LRU_BLOCK_DIM)
    gate_a = jax.nn.sigmoid(jnp.einsum("btnd,nde->btne", blocks, lru_wa).reshape(bsz, seq, LRU_WIDTH) + lru_ba)
    gate_x = jax.nn.sigmoid(jnp.einsum("btnd,nde->btne", blocks, lru_wx).reshape(bsz, seq, LRU_WIDTH) + lru_bx)
    log_a = -LRU_C * gate_a.astype(jnp.float32) * jax.nn.softplus(-lru_lambda.astype(jnp.float32))
    a = jnp.exp(log_a)
    mult = jnp.sqrt(-jnp.expm1(2.0 * log_a))
    mult = jnp.where(jnp.arange(seq)[None, :, None] == 0, 1.0, mult)
    b = (xb * gate_x).astype(jnp.float32) * mult

    def combine(c1, c2):
        a1, b1 = c1
        a2, b2 = c2
        return a1 * a2, a2 * b1 + b2

    _, h = lax.associative_scan(combine, (a, b), axis=1)
    return h.astype(xb.dtype) * jax.nn.gelu(gate_in)


def _hybrid_mixer(h, v_first, v_mix, w_in, shift_mu, w0, w_up, a0, a_up, g_up, k_k, k_a, r_k,
                  ln_w, ln_b, conv_w, conv_b, lru_wa, lru_ba, lru_wx, lru_bx, lru_lambda,
                  p_rwkv, p_lru, w_out):
    proj = h @ w_in
    p_shift, lru_x, lru_gate, gate_r, gate_l = jnp.split(
        proj, [W_SHIFT, W_SHIFT + LRU_WIDTH, W_SHIFT + 2 * LRU_WIDTH,
               W_SHIFT + 2 * LRU_WIDTH + D_MODEL], axis=-1)
    p_shift = p_shift + shift_mu * (_token_shift(p_shift) - p_shift)
    o_a, v_first = _rwkv7_branch(p_shift, v_first, v_mix, w0, w_up, a0, a_up, g_up,
                                 k_k, k_a, r_k, ln_w, ln_b)
    o_b = _rglru_branch(lru_x, lru_gate, conv_w, conv_b, lru_wa, lru_ba, lru_wx, lru_bx, lru_lambda)
    y = (jax.nn.sigmoid(gate_r) * (o_a.astype(h.dtype) @ p_rwkv)
         + jax.nn.sigmoid(gate_l) * (o_b @ p_lru))
    return y @ w_out, v_first


def setup_inputs(seed: int = 0) -> dict:
    key = jax.random.key(seed)
    ks = jax.random.split(key, 32)
    f32 = jnp.float32

    def nrm(k, shape, fan_in, scale=1.0):
        return jax.random.normal(k, shape, f32) * (scale * fan_in ** -0.5)

    L, D, RW, LW = DEPTH, D_MODEL, RWKV_WIDTH, LRU_WIDTH
    u = jax.random.uniform(ks[29], (L, LW), f32, minval=0.9, maxval=0.999)
    s = u ** (1.0 / LRU_C)
    return {
        "x": jax.random.normal(ks[0], (BATCH, SEQ, D), f32),
        "norm_g": 1.0 + 0.02 * jax.random.normal(ks[1], (L, N_NORMS, D), f32),
        "ffn1_w_up": nrm(ks[2], (L, D, 2 * D_FF), D),
        "ffn1_w_down": nrm(ks[3], (L, D_FF, D), D_FF),
        "ffn2_w_up": nrm(ks[4], (L, D, 2 * D_FF), D),
        "ffn2_w_down": nrm(ks[5], (L, D_FF, D), D_FF),
        "w_in": nrm(ks[6], (L, D, W_IN), D),
        "shift_mu": jax.random.uniform(ks[7], (L, W_SHIFT), f32),
        "w0": jax.random.uniform(ks[8], (L, RW), f32, minval=-6.0, maxval=1.0),
        "w_up": nrm(ks[9], (L, DECAY_LORA, RW), DECAY_LORA, 0.5),
        "a0": 0.1 * jax.random.normal(ks[10], (L, RW), f32),
        "a_up": nrm(ks[11], (L, AAA_LORA, RW), AAA_LORA),
        "g_up": nrm(ks[12], (L, GATE_LORA, RW), GATE_LORA),
        "k_k": 0.85 + 0.05 * jax.random.normal(ks[13], (L, RW), f32),
        "k_a": 1.0 + 0.05 * jax.random.normal(ks[14], (L, RW), f32),
        "r_k": 0.1 * jax.random.normal(ks[15], (L, RW), f32),
        "ln_w": 1.0 + 0.02 * jax.random.normal(ks[16], (L, RW), f32),
        "ln_b": 0.02 * jax.random.normal(ks[17], (L, RW), f32),
        "v0": 0.5 + 0.1 * jax.random.normal(ks[18], (L - 1, RW), f32),
        "v_down": nrm(ks[19], (L - 1, RW, MV_LORA), RW),
        "v_up": nrm(ks[20], (L - 1, MV_LORA, RW), MV_LORA),
        "conv_w": nrm(ks[21], (L, CONV_WIDTH, LW), CONV_WIDTH),
        "conv_b": 0.02 * jax.random.normal(ks[22], (L, LW), f32),
        "lru_wa": nrm(ks[23], (L, LRU_BLOCKS, LRU_BLOCK_DIM, LRU_BLOCK_DIM), LRU_BLOCK_DIM),
        "lru_ba": 0.02 * jax.random.normal(ks[24], (L, LW), f32),
        "lru_wx": nrm(ks[25], (L, LRU_BLOCKS, LRU_BLOCK_DIM, LRU_BLOCK_DIM), LRU_BLOCK_DIM),
        "lru_bx": 0.02 * jax.random.normal(ks[26], (L, LW), f32),
        "lru_lambda": jnp.log(s) - jnp.log1p(-s),
        "p_rwkv": nrm(ks[27], (L, RW, D), RW),
        "p_lru": nrm(ks[28], (L, LW, D), LW),
        "w_out": nrm(ks[30], (L, D, D), D),
    }


def reference(x, norm_g, ffn1_w_up, ffn1_w_down, ffn2_w_up, ffn2_w_down, w_in, shift_mu,
              w0, w_up, a0, a_up, g_up, k_k, k_a, r_k, ln_w, ln_b, v0, v_down, v_up,
              conv_w, conv_b, lru_wa, lru_ba, lru_wx, lru_bx, lru_lambda, p_rwkv, p_lru, w_out):
    v_first = None
    for l in range(DEPTH):
        g = norm_g[l]
        h = _swiglu(_rmsnorm(x, g[0]), ffn1_w_up[l], ffn1_w_down[l])
        x = x + 0.5 * _rmsnorm(h, g[1])
        v_mix = None if l == 0 else (v0[l - 1], v_down[l - 1], v_up[l - 1])
        h, v_first = _hybrid_mixer(
            _rmsnorm(x, g[2]), v_first, v_mix, w_in[l], shift_mu[l], w0[l], w_up[l], a0[l],
            a_up[l], g_up[l], k_k[l], k_a[l], r_k[l], ln_w[l], ln_b[l], conv_w[l], conv_b[l],
            lru_wa[l], lru_ba[l], lru_wx[l], lru_bx[l], lru_lambda[l], p_rwkv[l], p_lru[l], w_out[l])
        x = x + _rmsnorm(h, g[3])
        h = _swiglu(_rmsnorm(x, g[4]), ffn2_w_up[l], ffn2_w_down[l])
        x = x + 0.5 * _rmsnorm(h, g[5])
    return x
```

```cpp
#include <hip/hip_runtime.h>
#include <cstdio>
#include <cstdint>
#define DBG_ZERO_OA 0
#define DBG_ZERO_OB 0
#define DBG_NO_STATE 0
#define DBG_NO_CARRY 0
#define DBG_ZLO 0
#define DBG_ZHI 0
#define DBG_CHECK 0
#define DBG_LAYER 0
#define DBG_THR 0.02f
#define DBG_LAST_PHASE 28
#define DBG_DUMP_OFF WS_XN
#define DBG_SUB 0
#define DBG_SEQ 0
#define DBG_WCHECK 0
#define DBG_NAIVE 0
#define DBG_NLAYERS 3
#define DBG_SPLIT8 0
#define DBG_NAIVEG 0
#define DBG_SIGLATE 0
namespace pg8 {
#define PG8_LAS __attribute__((address_space(3)))
typedef unsigned short bf16_t;
typedef short bf16x8 __attribute__((ext_vector_type(8)));
typedef float f32x4 __attribute__((ext_vector_type(4)));
typedef unsigned u32x4 __attribute__((ext_vector_type(4)));
constexpr int BM = 256, BK = 64, HALF = 128, HTB = HALF * BK * 2  , STAGE_BYTES = 8 * HTB, NXCD = 8, WGM = 8;

__host__ __device__ __forceinline__ int lds_byte(int r, int c) { const int st = (r >> 4) * 2 + (c >> 5), rr = r & 15, cc = c & 31, ob = rr * 64 + cc * 2; return st * 1024 + (ob ^ (((ob >> 9) & 1) << 5)); }
__host__ __device__ __forceinline__ void stage_rc(int b, int& R, int& C) { const int st = b / 1024, sb = b % 1024, swz = sb ^ (((sb >> 9) & 1) << 5); R = (st >> 1) * 16 + swz / 64; C = (st & 1) * 32 + (swz % 64) / 2; }
__host__ __device__ __forceinline__ int perm32(int rho) { const int n = rho >> 4, i = rho & 15; return 8 * (i >> 2) + 4 * n + (i & 3); }

struct Unit { int pm, pn; };
struct Gemm { const bf16_t* A; const bf16_t* Bt; int M, N, K; };

struct StaticOrder {
    int nM, nN, nwg, G, c;
    __host__ __device__ void init(int M, int N, int G_, int c_) { nM = M / BM; nN = N / BM; nwg = nM * nN; G = G_; c = c_; }
    __host__ __device__ bool next(int i, Unit& u) const {
        const long L = (long)i * G + c; if (L >= nwg) return false;
        int wgid = (int)L; { const int q = nwg / NXCD, r = nwg % NXCD, xcd = wgid % NXCD, off = wgid / NXCD; wgid = (xcd < r ? xcd * (q + 1) : r * (q + 1) + (xcd - r) * q) + off; }
        const int nig = WGM * nN, gid = wgid / nig, fm = gid * WGM, gsz = (nM - fm) < WGM ? (nM - fm) : WGM;
        u.pm = fm + ((wgid % nig) % gsz); u.pn = (wgid % nig) / gsz; return true;
    }
    __device__ __forceinline__ void a_ready(const Unit&) const {}
    __device__ __forceinline__ void done(const Unit&) const {}
};

__device__ __forceinline__ unsigned cvt_pk_bf16(float lo, float hi) { unsigned r; asm volatile("v_cvt_pk_bf16_f32 %0, %1, %2" : "=v"(r) : "v"(lo), "v"(hi)); return r; }
typedef float f32x2 __attribute__((ext_vector_type(2)));
__device__ __forceinline__ f32x2 gelu_pk(f32x2 v) {
    const f32x2 av = __builtin_elementwise_abs(v), d = av * 0.2316418882f + 1.0f;
    f32x2 t; t.x = __builtin_amdgcn_rcpf(d.x); t.y = __builtin_amdgcn_rcpf(d.y);
    f32x2 q = t * 0.5307027145f + (-0.7265760135f); q = q * t + 0.7107068705f; q = q * t + (-0.142248368f); q = q * t + 0.127414796f; q = q * t;
    const f32x2 s = (v * v) * (-0.72134752044f);
    f32x2 e; e.x = __builtin_amdgcn_exp2f(s.x); e.y = __builtin_amdgcn_exp2f(s.y);
    const f32x2 m = v * (q * e), r = v - m;
    f32x2 o; o.x = v.x < 0.f ? m.x : r.x; o.y = v.y < 0.f ? m.y : r.y; return o;
}

template <int ACT  > struct EpiBf16 {
    static constexpr bool PERM = true, AFTER_DRAIN = false; static_assert(ACT == 0 || ACT == 1, "EpiBf16: ACT is 0 (none) or 1 (gelu_pk)");
    bf16_t* O; int ldc; const float* bias; int split_cols; size_t split_stride; float scale0;
    __device__ __forceinline__ void operator()(const f32x4 (&acc)[2][2][4][2], const Unit& u, int wr, int wc, int fr, int fq) const {
        const int row0 = u.pm * BM + wr * 64 + fr; int colt = u.pn * BM; bf16_t* base = O;
        float sc = 1.f; if (split_cols) { const int t = colt / split_cols; base += (size_t)t * split_stride; colt -= t * split_cols; if (t == 0) sc = scale0; }
        const int col0 = colt + wc * 32 + 8 * fq, bcol0 = u.pn * BM + wc * 32 + 8 * fq;
        f32x4 bv[2][2];
#pragma unroll
        for (int bj = 0; bj < 2; ++bj)
#pragma unroll
            for (int n = 0; n < 2; ++n) bv[bj][n] = bias ? *(const f32x4*)(bias + bcol0 + bj * HALF + 4 * n) : (f32x4){0.f, 0.f, 0.f, 0.f};
#pragma unroll
        for (int ai = 0; ai < 2; ++ai)
#pragma unroll
            for (int m = 0; m < 4; ++m) { bf16_t* rowp = base + (size_t)(row0 + ai * HALF + m * 16) * ldc + col0;
#pragma unroll
                for (int bj = 0; bj < 2; ++bj) { f32x4 v0 = acc[ai][bj][m][0] + bv[bj][0], v1 = acc[ai][bj][m][1] + bv[bj][1];
                    if (ACT == 1) { f32x2 a = gelu_pk((f32x2){v0[0], v0[1]}), b = gelu_pk((f32x2){v0[2], v0[3]}), c = gelu_pk((f32x2){v1[0], v1[1]}), d = gelu_pk((f32x2){v1[2], v1[3]});
                        v0 = (f32x4){a.x, a.y, b.x, b.y}; v1 = (f32x4){c.x, c.y, d.x, d.y}; }
                    v0 = v0 * sc; v1 = v1 * sc; u32x4 w; w.x = cvt_pk_bf16(v0[0], v0[1]); w.y = cvt_pk_bf16(v0[2], v0[3]); w.z = cvt_pk_bf16(v1[0], v1[1]); w.w = cvt_pk_bf16(v1[2], v1[3]);
                    *(u32x4*)(rowp + bj * HALF) = w; } }
    }
};

struct PanelStats {
    unsigned* xbuf;
    unsigned* cnt;
    unsigned* tmo;
    int ntn; float eps;
    unsigned code;
    __device__ __forceinline__ bool run(const f32x4 (&v)[2][2][4][2], const Unit& u, int wr, int wc, int fr, int fq, PG8_LAS unsigned char* lds, int wid, int lane) const {
        typedef float f32x2v __attribute__((ext_vector_type(2)));
        PG8_LAS f32x2v* P = (PG8_LAS f32x2v*)lds;
        PG8_LAS f32x2v* S = (PG8_LAS f32x2v*)(lds + 8192);
        PG8_LAS unsigned* flag = (PG8_LAS unsigned*)(lds + 8192 + 2048);
#pragma unroll
        for (int ai = 0; ai < 2; ++ai)
#pragma unroll
            for (int m = 0; m < 4; ++m) {
                float s = 0.f;
#pragma unroll
                for (int bj = 0; bj < 2; ++bj)
#pragma unroll
                    for (int n = 0; n < 2; ++n) { const f32x4 x = v[ai][bj][m][n]; s += (x[0] + x[1]) + (x[2] + x[3]); }
                s += __shfl_xor(s, 16); s += __shfl_xor(s, 32);
                const float mw = s * (1.0f / 64.0f); float q = 0.f;
#pragma unroll
                for (int bj = 0; bj < 2; ++bj)
#pragma unroll
                    for (int n = 0; n < 2; ++n) { const f32x4 d = v[ai][bj][m][n] - mw; q += (d[0] * d[0] + d[1] * d[1]) + (d[2] * d[2] + d[3] * d[3]); }
                q += __shfl_xor(q, 16); q += __shfl_xor(q, 32);
                if (fq == 0) P[(ai * HALF + wr * 64 + m * 16 + fr) * 4 + wc] = (f32x2v){mw, q};
            }
        asm volatile("s_waitcnt lgkmcnt(0)" ::: "memory"); __builtin_amdgcn_s_barrier(); asm volatile("" ::: "memory");
#if defined(BROKEN_EXCHANGE_NO_WAIT)
#warning BROKEN CONTROL BUILD: the row-statistics exchange does not wait; results are wrong by design
        if (blockIdx.x >= 64) { const long long t0_ = clock64(); while (clock64() - t0_ < 60000) __builtin_amdgcn_s_sleep(8); }
#endif
        const int row = wid * 32 + (lane & 31);
        if (lane < 32) {
            const f32x2v a = P[row * 4 + 0], b = P[row * 4 + 1], c = P[row * 4 + 2], d = P[row * 4 + 3];
            const float mt = (a.x + b.x + c.x + d.x) * 0.25f;
            const float da = a.x - mt, db = b.x - mt, dc = c.x - mt, dd = d.x - mt;
            const float m2 = (a.y + b.y) + (c.y + d.y) + 64.0f * ((da * da + db * db) + (dc * dc + dd * dd));
            unsigned long long* slot = (unsigned long long*)xbuf + ((size_t)(u.pm * BM + row) * 4 + u.pn);
            __hip_atomic_store(slot, ((unsigned long long)__float_as_uint(m2) << 32) | __float_as_uint(mt), __ATOMIC_RELAXED, __HIP_MEMORY_SCOPE_AGENT);
        }
        asm volatile("s_waitcnt vmcnt(0)" ::: "memory");
        if (lane == 0) __hip_atomic_fetch_add(cnt + 64 * u.pm, 1u, __ATOMIC_RELAXED, __HIP_MEMORY_SCOPE_AGENT);
        if (wid == 0) {
            bool dead = false; const unsigned long long t0 = __builtin_amdgcn_s_memrealtime(); const unsigned want = 8u * (unsigned)ntn;
            for (;;) {
#if defined(BROKEN_EXCHANGE_NO_WAIT)
                break;
#endif
                if ((unsigned)__builtin_amdgcn_readfirstlane(__hip_atomic_load(cnt + 64 * u.pm, __ATOMIC_RELAXED, __HIP_MEMORY_SCOPE_AGENT)) >= want) break;
                if (__builtin_amdgcn_s_memrealtime() - t0 > 2000000ull) {
                    if (lane == 0) { unsigned expect = 0u; __hip_atomic_compare_exchange_strong(tmo + 1, &expect, code | (unsigned)(u.pm & 0xff), __ATOMIC_RELAXED, __ATOMIC_RELAXED, __HIP_MEMORY_SCOPE_AGENT);
                                     __hip_atomic_store(tmo, 1u, __ATOMIC_RELAXED, __HIP_MEMORY_SCOPE_AGENT); }
                    dead = true; break; }
                __builtin_amdgcn_s_sleep(2);
            }
            __builtin_amdgcn_fence(__ATOMIC_ACQUIRE, "agent");
            if (lane == 0) flag[0] = dead ? 1u : 0u;
        }
        asm volatile("s_waitcnt vmcnt(0) lgkmcnt(0)" ::: "memory"); __builtin_amdgcn_s_barrier(); asm volatile("" ::: "memory");
        const bool bad = flag[0] != 0u;
        if (lane < 32) {
            const unsigned long long* slot = (const unsigned long long*)xbuf + (size_t)(u.pm * BM + row) * 4; float mt[4], m2[4]; float ms = 0.f;
#pragma unroll
            for (int t = 0; t < 4; ++t) { if (t < ntn) { const unsigned long long w = __hip_atomic_load(slot + t, __ATOMIC_RELAXED, __HIP_MEMORY_SCOPE_AGENT); mt[t] = __uint_as_float((unsigned)w); m2[t] = __uint_as_float((unsigned)(w >> 32)); } else { mt[t] = 0.f; m2[t] = 0.f; } ms += mt[t]; }
            const float mean = ms / (float)ntn; float q = 0.f;
#pragma unroll
            for (int t = 0; t < 4; ++t) if (t < ntn) { const float dm = mt[t] - mean; q += m2[t] + 256.0f * dm * dm; }
            S[row] = (f32x2v){mean, 1.0f / sqrtf(q / (256.0f * (float)ntn) + eps)};
        }
        asm volatile("s_waitcnt lgkmcnt(0)" ::: "memory"); __builtin_amdgcn_s_barrier(); asm volatile("" ::: "memory");
        return bad;
    }
};
struct EpiLnRes {
    static constexpr bool PERM = false, AFTER_DRAIN = true;
    const float* base; float* out; int ldc; const float* bias; PanelStats st; unsigned poison;
    __device__ __forceinline__ void fused(f32x4 (&acc)[2][2][4][2], const Unit& u, int wr, int wc, int fr, int fq, PG8_LAS unsigned char* lds, int wid, int lane) const {
        typedef float f32x2v __attribute__((ext_vector_type(2)));
        const PG8_LAS f32x2v* S = (const PG8_LAS f32x2v*)(lds + 8192);
        const int col0 = u.pn * BM + wc * 32 + 4 * fq;
#pragma unroll
        for (int bj = 0; bj < 2; ++bj)
#pragma unroll
            for (int n = 0; n < 2; ++n) { const f32x4 bv = bias ? *(const f32x4*)(bias + col0 + bj * HALF + n * 16) : (f32x4){0.f, 0.f, 0.f, 0.f};
#pragma unroll
                for (int ai = 0; ai < 2; ++ai)
#pragma unroll
                    for (int m = 0; m < 4; ++m) acc[ai][bj][m][n] += bv; }
        f32x4 pre[4][2][2];
#pragma unroll
        for (int m = 0; m < 4; ++m) { const size_t off = (size_t)(u.pm * BM + wr * 64 + m * 16 + fr) * ldc + col0;
#pragma unroll
            for (int bj = 0; bj < 2; ++bj)
#pragma unroll
                for (int n = 0; n < 2; ++n) pre[m][bj][n] = *(const f32x4*)(base + off + bj * HALF + n * 16); }
        const bool bad = st.run(acc, u, wr, wc, fr, fq, lds, wid, lane) || poison != 0u;
        const float qnan = __builtin_nanf("");
#pragma unroll
        for (int ai = 0; ai < 2; ++ai)
#pragma unroll
            for (int m = 0; m < 4; ++m) { const int r = ai * HALF + wr * 64 + m * 16 + fr; const f32x2v sr = S[r]; const size_t off = (size_t)(u.pm * BM + r) * ldc + col0;
#pragma unroll
                for (int bj = 0; bj < 2; ++bj)
#pragma unroll
                    for (int n = 0; n < 2; ++n) { const f32x4 bs = ai == 0 ? pre[m][bj][n] : *(const f32x4*)(base + off + bj * HALF + n * 16); f32x4 o = bs + (acc[ai][bj][m][n] - sr.x) * sr.y;
                        if (bad) o = (f32x4){qnan, qnan, qnan, qnan}; *(f32x4*)(out + off + bj * HALF + n * 16) = o; }
                if (m & 1) asm volatile("" ::: "memory"); }
    }
};
struct EpiLnResLn {
    static constexpr bool PERM = false, AFTER_DRAIN = true;
    const float* base; float* out; bf16_t* xn; int ldc; const float* bias; PanelStats st1, st2; unsigned poison;
    __device__ __forceinline__ void fused(f32x4 (&acc)[2][2][4][2], const Unit& u, int wr, int wc, int fr, int fq, PG8_LAS unsigned char* lds, int wid, int lane) const {
        typedef float f32x2v __attribute__((ext_vector_type(2))); typedef unsigned u32x2v __attribute__((ext_vector_type(2)));
        const PG8_LAS f32x2v* S = (const PG8_LAS f32x2v*)(lds + 8192);
        const int col0 = u.pn * BM + wc * 32 + 4 * fq;
#pragma unroll
        for (int bj = 0; bj < 2; ++bj)
#pragma unroll
            for (int n = 0; n < 2; ++n) { const f32x4 bv = bias ? *(const f32x4*)(bias + col0 + bj * HALF + n * 16) : (f32x4){0.f, 0.f, 0.f, 0.f};
#pragma unroll
                for (int ai = 0; ai < 2; ++ai)
#pragma unroll
                    for (int m = 0; m < 4; ++m) acc[ai][bj][m][n] += bv; }
        bool bad = st1.run(acc, u, wr, wc, fr, fq, lds, wid, lane) || poison != 0u;
        const float qnan = __builtin_nanf("");
#pragma unroll
        for (int ai = 0; ai < 2; ++ai)
#pragma unroll
            for (int m = 0; m < 4; ++m) { const int r = ai * HALF + wr * 64 + m * 16 + fr; const f32x2v sr = S[r]; const size_t off = (size_t)(u.pm * BM + r) * ldc + col0;
#pragma unroll
                for (int bj = 0; bj < 2; ++bj)
#pragma unroll
                    for (int n = 0; n < 2; ++n) { const f32x4 bs = *(const f32x4*)(base + off + bj * HALF + n * 16); acc[ai][bj][m][n] = bs + (acc[ai][bj][m][n] - sr.x) * sr.y; }
                asm volatile("" : "+v"(acc[ai][0][m][0]), "+v"(acc[ai][0][m][1]), "+v"(acc[ai][1][m][0]), "+v"(acc[ai][1][m][1]));
                if (m & 1) asm volatile("" ::: "memory"); }
        const bool bad1 = bad;
        bad = st2.run(acc, u, wr, wc, fr, fq, lds, wid, lane) || bad;
#pragma unroll
        for (int ai = 0; ai < 2; ++ai)
#pragma unroll
            for (int m = 0; m < 4; ++m) { const int r = ai * HALF + wr * 64 + m * 16 + fr; const f32x2v sr = S[r]; const size_t off = (size_t)(u.pm * BM + r) * ldc + col0;
#pragma unroll
                for (int bj = 0; bj < 2; ++bj)
#pragma unroll
                    for (int n = 0; n < 2; ++n) { const f32x4 x1 = acc[ai][bj][m][n]; *(f32x4*)(out + off + bj * HALF + n * 16) = bad1 ? (f32x4){qnan, qnan, qnan, qnan} : x1;
                        const f32x4 o = (x1 - sr.x) * sr.y; u32x2v w; w.x = cvt_pk_bf16(o[0], o[1]); w.y = cvt_pk_bf16(o[2], o[3]);
                        if (bad) { w.x = 0x7fc07fc0u; w.y = 0x7fc07fc0u; } *(u32x2v*)(xn + off + bj * HALF + n * 16) = w; }
                asm volatile("" ::: "memory"); }
    }
};

template <class Epi, class Sched, bool ALIGN_EPI = false, bool SP2 = false>
__device__ __forceinline__ void gemm_phase(PG8_LAS unsigned char* lds, const Gemm g, const Sched& S, const Epi& E) {
    int tid_l = threadIdx.x; asm volatile("" : "+v"(tid_l));
    const int tid = tid_l, wid = __builtin_amdgcn_readfirstlane(tid >> 6), lane = tid & 63, wr = wid >> 2, wc = wid & 3, fr = lane & 15, fq = lane >> 4;
    const int K = g.K, nt = K / BK;
    unsigned voffA[2], voffB[2];
#pragma unroll
    for (int i = 0; i < 2; ++i) { int R, C; stage_rc(tid * 16 + i * 8192, R, C); const int Rb = Epi::PERM ? ((R & ~31) + perm32(R & 31)) : R;
        voffA[i] = (unsigned)(R * K + C) * 2u; voffB[i] = (unsigned)(Rb * K + C) * 2u; }
    const size_t kstep = (size_t)(BK * 2);
    const size_t hstep = (size_t)HALF * K * 2;
    const size_t tstep = 2 * hstep;
    const unsigned ldsw = (unsigned)wid * 1024u;
    const int aoff = lds_byte(wr * 64 + fr, fq * 8), boff = lds_byte(wc * 32 + fr, fq * 8);
#define PG8_SA(b, h) (((b) * 2 + (h)) * HTB)
#define PG8_SB(b, h) ((4 + (b) * 2 + (h)) * HTB)
#define PG8_STAGE(bufoff, gbase, voff) do { _Pragma("unroll") for (int _i = 0; _i < 2; ++_i) \
        __builtin_amdgcn_global_load_lds((const unsigned*)((const char*)(gbase) + (voff)[_i]), (PG8_LAS unsigned*)(lds + (bufoff) + ldsw + _i * 8192), 16, 0, 0); } while (0)
#define PG8_LDA(dst, b, h) do { _Pragma("unroll") for (int m = 0; m < 4; ++m) _Pragma("unroll") for (int k = 0; k < 2; ++k) dst[m][k] = *(const PG8_LAS bf16x8*)(lds + PG8_SA(b, h) + aoff + m * 2048 + k * 1024); } while (0)
#define PG8_LDB(dst, b, h) do { _Pragma("unroll") for (int n = 0; n < 2; ++n) _Pragma("unroll") for (int k = 0; k < 2; ++k) dst[n][k] = *(const PG8_LAS bf16x8*)(lds + PG8_SB(b, h) + boff + n * 2048 + k * 1024); } while (0)
#define PG8_MMA(ai, bj, At, Bt) do { __builtin_amdgcn_s_setprio(1); _Pragma("unroll") for (int m = 0; m < 4; ++m) _Pragma("unroll") for (int n = 0; n < 2; ++n) _Pragma("unroll") for (int k = 0; k < 2; ++k) \
        acc[ai][bj][m][n] = __builtin_amdgcn_mfma_f32_16x16x32_bf16(Bt[n][k], At[m][k], acc[ai][bj][m][n], 0, 0, 0); __builtin_amdgcn_s_setprio(0); } while (0)
#define PG8_WAIT_V(n) asm volatile("s_waitcnt vmcnt(" #n ")" ::: "memory")
#define PG8_WAIT_L(n) asm volatile("s_waitcnt lgkmcnt(" #n ")" ::: "memory")
#define PG8_BAR __builtin_amdgcn_s_barrier()
#define PG8_SCHED __builtin_amdgcn_sched_barrier(0)
    Unit cur, nxt; int ui = 0;
    if (!S.next(0, cur)) return;
    f32x4 acc[2][2][4][2];
#pragma unroll
    for (int a = 0; a < 2; ++a)
#pragma unroll
        for (int b = 0; b < 2; ++b)
#pragma unroll
            for (int m = 0; m < 4; ++m)
#pragma unroll
                for (int n = 0; n < 2; ++n) acc[a][b][m][n] = (f32x4){0.f, 0.f, 0.f, 0.f};
    bf16x8 At[4][2], B0[2][2], B1[2][2];
    const char* cA = (const char*)g.A + (size_t)cur.pm * tstep; const char* cB = (const char*)g.Bt + (size_t)cur.pn * tstep;
    S.a_ready(cur);
    if constexpr (SP2) {
        PG8_STAGE(PG8_SB(0, 0), cB, voffB); PG8_STAGE(PG8_SB(0, 1), cB + hstep, voffB); PG8_STAGE(PG8_SA(0, 0), cA, voffA); PG8_STAGE(PG8_SA(0, 1), cA + hstep, voffA);
        if (wr == 1) PG8_BAR;
        PG8_WAIT_V(2); PG8_BAR;
        PG8_STAGE(PG8_SB(1, 0), cB + kstep, voffB); PG8_STAGE(PG8_SA(1, 0), cA + kstep, voffA); PG8_STAGE(PG8_SB(1, 1), cB + hstep + kstep, voffB);
        PG8_WAIT_V(6); PG8_BAR;
    } else {
        PG8_STAGE(PG8_SB(0, 0), cB, voffB); PG8_STAGE(PG8_SA(0, 0), cA, voffA); PG8_STAGE(PG8_SB(0, 1), cB + hstep, voffB); PG8_STAGE(PG8_SA(0, 1), cA + hstep, voffA);
        if (wr == 1) PG8_BAR;
        PG8_WAIT_V(4); PG8_BAR;
        PG8_STAGE(PG8_SB(1, 0), cB + kstep, voffB); PG8_STAGE(PG8_SA(1, 0), cA + kstep, voffA); PG8_STAGE(PG8_SB(1, 1), cB + hstep + kstep, voffB);
        PG8_WAIT_V(6); PG8_BAR;
    }
    for (;;) {
        const bool has_next = S.next(ui + 1, nxt);
        const char* nA = has_next ? (const char*)g.A + (size_t)nxt.pm * tstep : cA; const char* nB = has_next ? (const char*)g.Bt + (size_t)nxt.pn * tstep : cB;
        for (int t = 0; t < nt; t += 2) {
            const bool last = (t == nt - 2);
            const char* a1 = cA + (size_t)(t + 1) * kstep;
            const char* a2 = last ? nA : cA + (size_t)(t + 2) * kstep; const char* b2 = last ? nB : cB + (size_t)(t + 2) * kstep;
            const char* a3 = a2 + kstep; const char* b3 = b2 + kstep;
            if (last && has_next) S.a_ready(nxt);
            if constexpr (SP2) {
            PG8_LDB(B0, 0, 0); PG8_LDB(B1, 0, 1); PG8_SCHED; PG8_LDA(At, 0, 0); PG8_STAGE(PG8_SA(1, 1), a1 + hstep, voffA);
            PG8_WAIT_V(8); PG8_WAIT_L(0); PG8_BAR; PG8_MMA(0, 0, At, B0); PG8_MMA(0, 1, At, B1); PG8_BAR; PG8_SCHED;
            PG8_LDA(At, 0, 1); PG8_STAGE(PG8_SB(0, 0), b2, voffB); PG8_STAGE(PG8_SB(0, 1), b2 + hstep, voffB); PG8_STAGE(PG8_SA(0, 0), a2, voffA);
            PG8_WAIT_V(8); PG8_WAIT_L(0); PG8_BAR; PG8_MMA(1, 0, At, B0); PG8_MMA(1, 1, At, B1); PG8_BAR; PG8_SCHED;
            PG8_LDB(B0, 1, 0); PG8_LDB(B1, 1, 1); PG8_SCHED; PG8_LDA(At, 1, 0); PG8_STAGE(PG8_SA(0, 1), a2 + hstep, voffA);
            PG8_WAIT_V(8); PG8_WAIT_L(0); PG8_BAR; PG8_MMA(0, 0, At, B0); PG8_MMA(0, 1, At, B1); PG8_BAR; PG8_SCHED;
            PG8_LDA(At, 1, 1); PG8_STAGE(PG8_SB(1, 0), b3, voffB); PG8_STAGE(PG8_SB(1, 1), b3 + hstep, voffB); PG8_STAGE(PG8_SA(1, 0), a3, voffA);
            PG8_WAIT_V(8); PG8_WAIT_L(0); PG8_BAR; PG8_MMA(1, 0, At, B0); PG8_MMA(1, 1, At, B1); PG8_BAR; PG8_SCHED;
            } else {
            PG8_LDB(B0, 0, 0); PG8_SCHED; PG8_LDA(At, 0, 0); PG8_STAGE(PG8_SA(1, 1), a1 + hstep, voffA);
            PG8_WAIT_L(8); PG8_BAR; PG8_WAIT_L(0); PG8_MMA(0, 0, At, B0); PG8_BAR; PG8_SCHED;
            PG8_LDB(B1, 0, 1); PG8_STAGE(PG8_SB(0, 0), b2, voffB);
            PG8_BAR; PG8_WAIT_L(0); PG8_MMA(0, 1, At, B1); PG8_BAR;
            PG8_LDA(At, 0, 1); PG8_STAGE(PG8_SA(0, 0), a2, voffA);
            PG8_BAR; PG8_WAIT_L(0); PG8_MMA(1, 0, At, B0); PG8_BAR; PG8_SCHED;
            PG8_STAGE(PG8_SB(0, 1), b2 + hstep, voffB);
            PG8_WAIT_V(6); PG8_BAR; PG8_MMA(1, 1, At, B1); PG8_BAR;
            PG8_LDB(B0, 1, 0); PG8_SCHED; PG8_LDA(At, 1, 0); PG8_STAGE(PG8_SA(0, 1), a2 + hstep, voffA);
            PG8_WAIT_L(8); PG8_BAR; PG8_WAIT_L(0); PG8_MMA(0, 0, At, B0); PG8_BAR; PG8_SCHED;
            PG8_LDB(B1, 1, 1); PG8_STAGE(PG8_SB(1, 0), b3, voffB);
            PG8_BAR; PG8_WAIT_L(0); PG8_MMA(0, 1, At, B1); PG8_BAR;
            PG8_LDA(At, 1, 1); PG8_STAGE(PG8_SA(1, 0), a3, voffA);
            PG8_BAR; PG8_WAIT_L(0); PG8_MMA(1, 0, At, B0); PG8_BAR; PG8_SCHED;
            PG8_STAGE(PG8_SB(1, 1), b3 + hstep, voffB);
            PG8_WAIT_V(6); PG8_BAR; PG8_MMA(1, 1, At, B1); PG8_BAR;
            }
        }
        if constexpr (ALIGN_EPI) { if (wr == 0) PG8_BAR; }
        if constexpr (!Epi::AFTER_DRAIN) { E(acc, cur, wr, wc, fr, fq); S.done(cur); }
        if (!has_next) break;
#pragma unroll
        for (int a = 0; a < 2; ++a)
#pragma unroll
            for (int b = 0; b < 2; ++b)
#pragma unroll
                for (int m = 0; m < 4; ++m)
#pragma unroll
                    for (int n = 0; n < 2; ++n) acc[a][b][m][n] = (f32x4){0.f, 0.f, 0.f, 0.f};
        cur = nxt; cA = nA; cB = nB; ++ui;
        if constexpr (ALIGN_EPI) { if (wr == 1) PG8_BAR; }
    }
    PG8_WAIT_V(0);
    if constexpr (!ALIGN_EPI) { if (wr == 0) PG8_BAR; }
    PG8_BAR;
    if constexpr (Epi::AFTER_DRAIN) { E.fused(acc, cur, wr, wc, fr, fq, lds, wid, lane); S.done(cur); }
#undef PG8_SA
#undef PG8_SB
#undef PG8_STAGE
#undef PG8_LDA
#undef PG8_LDB
#undef PG8_MMA
#undef PG8_WAIT_V
#undef PG8_WAIT_L
#undef PG8_BAR
#undef PG8_SCHED
}
}
namespace pg8 {
__device__ __forceinline__ float sigmoidf_fast(float x) { return __builtin_amdgcn_rcpf(1.0f + __expf(-x)); }
typedef float f32x2_c __attribute__((ext_vector_type(2))); typedef __bf16 bf16x2_c __attribute__((ext_vector_type(2)));
__device__ __forceinline__ unsigned cvt_pk_safe(float lo, float hi) { const f32x2_c v = {lo, hi}; const bf16x2_c b = __builtin_convertvector(v, bf16x2_c); return __builtin_bit_cast(unsigned, b); }
struct EpiSwiglu {
    static constexpr bool PERM = true, AFTER_DRAIN = false;
    bf16_t* O; int ldc;
    __device__ __forceinline__ void operator()(const f32x4 (&acc)[2][2][4][2], const Unit& u, int wr, int wc, int fr, int fq) const {
        const int row0 = u.pm * BM + wr * 64 + fr, col0 = u.pn * HALF + wc * 32 + 8 * fq;
#pragma unroll
        for (int ai = 0; ai < 2; ++ai)
#pragma unroll
            for (int m = 0; m < 4; ++m) { bf16_t* rowp = O + (size_t)(row0 + ai * HALF + m * 16) * ldc + col0;
                float v[8];
#pragma unroll
                for (int n = 0; n < 2; ++n)
#pragma unroll
                    for (int e = 0; e < 4; ++e) { const float g = acc[ai][0][m][n][e], up = acc[ai][1][m][n][e]; v[n * 4 + e] = g * sigmoidf_fast(g) * up; }
                u32x4 w; w.x = cvt_pk_safe(v[0], v[1]); w.y = cvt_pk_safe(v[2], v[3]); w.z = cvt_pk_safe(v[4], v[5]); w.w = cvt_pk_safe(v[6], v[7]);
                *(u32x4*)rowp = w; }
    }
};
template <int ACT> struct EpiMap {
    static constexpr bool PERM = true, AFTER_DRAIN = false;
    bf16_t* O0; int ld0; int t1; bf16_t* O1; int ld1;
    __device__ __forceinline__ void operator()(const f32x4 (&acc)[2][2][4][2], const Unit& u, int wr, int wc, int fr, int fq) const {
        const int row0 = u.pm * BM + wr * 64 + fr;
        bf16_t* base; int ld, colt;
        if (u.pn < t1) { base = O0; ld = ld0; colt = u.pn * BM; } else { base = O1; ld = ld1; colt = (u.pn - t1) * BM; }
        const int col0 = colt + wc * 32 + 8 * fq;
#pragma unroll
        for (int ai = 0; ai < 2; ++ai)
#pragma unroll
            for (int m = 0; m < 4; ++m) { bf16_t* rowp = base + (size_t)(row0 + ai * HALF + m * 16) * ld + col0;
#pragma unroll
                for (int bj = 0; bj < 2; ++bj) { f32x4 v0 = acc[ai][bj][m][0], v1 = acc[ai][bj][m][1];
                    if (ACT == 1) {
#pragma unroll
                        for (int e = 0; e < 4; ++e) { v0[e] = sigmoidf_fast(v0[e]); v1[e] = sigmoidf_fast(v1[e]); } }
                    u32x4 w; w.x = cvt_pk_safe(v0[0], v0[1]); w.y = cvt_pk_safe(v0[2], v0[3]); w.z = cvt_pk_safe(v1[0], v1[1]); w.w = cvt_pk_safe(v1[2], v1[3]);
                    *(u32x4*)(rowp + bj * HALF) = w; } }
    }
};
__device__ __forceinline__ float bfu_lo(unsigned w) { return __uint_as_float(w << 16); }
__device__ __forceinline__ float bfu_hi(unsigned w) { return __uint_as_float(w & 0xffff0000u); }
template <int MODE> struct EpiGateMerge {
    static constexpr bool PERM = true, AFTER_DRAIN = false;
    bf16_t* Y; int ldy; const bf16_t* G; int ldg; int goff;
    __device__ __forceinline__ void operator()(const f32x4 (&acc)[2][2][4][2], const Unit& u, int wr, int wc, int fr, int fq) const {
        const int row0 = u.pm * BM + wr * 64 + fr, col0 = u.pn * BM + wc * 32 + 8 * fq;
#pragma unroll
        for (int ai = 0; ai < 2; ++ai)
#pragma unroll
            for (int m = 0; m < 4; ++m) { const size_t r = (size_t)(row0 + ai * HALF + m * 16);
#pragma unroll
                for (int bj = 0; bj < 2; ++bj) { const int c = col0 + bj * HALF;
                    const u32x4 gv = *(const u32x4*)(G + r * ldg + goff + c);
                    const f32x4 a0 = acc[ai][bj][m][0], a1 = acc[ai][bj][m][1];
                    float v[8];
                    float gq[8] = {bfu_lo(gv.x), bfu_hi(gv.x), bfu_lo(gv.y), bfu_hi(gv.y), bfu_lo(gv.z), bfu_hi(gv.z), bfu_lo(gv.w), bfu_hi(gv.w)};
#if DBG_SIGLATE
#pragma unroll
                    for (int e = 0; e < 8; ++e) gq[e] = sigmoidf_fast(gq[e]);
#endif
                    v[0] = gq[0] * a0[0]; v[1] = gq[1] * a0[1]; v[2] = gq[2] * a0[2]; v[3] = gq[3] * a0[3];
                    v[4] = gq[4] * a1[0]; v[5] = gq[5] * a1[1]; v[6] = gq[6] * a1[2]; v[7] = gq[7] * a1[3];
                    if (MODE == 1) { const u32x4 yv = *(const u32x4*)(Y + r * ldy + c);
                        v[0] += bfu_lo(yv.x); v[1] += bfu_hi(yv.x); v[2] += bfu_lo(yv.y); v[3] += bfu_hi(yv.y);
                        v[4] += bfu_lo(yv.z); v[5] += bfu_hi(yv.z); v[6] += bfu_lo(yv.w); v[7] += bfu_hi(yv.w); }
                    u32x4 w; w.x = cvt_pk_safe(v[0], v[1]); w.y = cvt_pk_safe(v[2], v[3]); w.z = cvt_pk_safe(v[4], v[5]); w.w = cvt_pk_safe(v[6], v[7]);
                    *(u32x4*)(Y + r * ldy + c) = w; } }
    }
};
struct PairOrder { Unit base;
    __device__ __forceinline__ bool next(int i, Unit& u) const { if (i >= 2) return false; u.pm = base.pm; u.pn = base.pn + 4 * i; return true; }
    __device__ __forceinline__ void a_ready(const Unit&) const {}
    __device__ __forceinline__ void done(const Unit&) const {} };
struct OneUnit { Unit base;
    __device__ __forceinline__ bool next(int i, Unit& u) const { if (i >= 1) return false; u = base; return true; }
    __device__ __forceinline__ void a_ready(const Unit&) const {}
    __device__ __forceinline__ void done(const Unit&) const {} };
}
constexpr int NWAVES = 8, GRID = 256;
constexpr int BATCH = 2, T = 8192, M = BATCH * T, D = 1024, FF = 2816, NUP = 2 * FF, WIN = 4864, WSH = 1792, RW = 512, LW = 512, NH = 8, HD = 64;
constexpr int NAL = 2816;
constexpr int NGT = 2048;
constexpr int NCHUNK = M / 64;
constexpr int NCH_SEQ = T / 64;
constexpr float RMS_EPS = 1e-6f, GN_EPS = 64e-5f;
constexpr int PH_PER_LAYER = 14, N_PHASES = 2 * PH_PER_LAYER;

constexpr size_t MiB = 1u << 20;
constexpr size_t WS_CTL = 0, CTL_ZERO_BYTES = 64 * 1024;
constexpr size_t WS_WUP = 1 * MiB;
constexpr size_t WS_WDN = WS_WUP + (size_t)NUP * D * 2;
constexpr size_t WS_WIN = 18 * MiB;
constexpr size_t WS_PAT = WS_WIN + (size_t)WIN * D * 2;
constexpr size_t WS_PBT = WS_PAT + (size_t)D * RW * 2;
constexpr size_t WS_WOT = WS_PBT + (size_t)D * LW * 2;
constexpr size_t WS_SMALL = WS_WOT + (size_t)D * D * 2;
constexpr size_t WS_WUT = WS_SMALL;
constexpr size_t WS_AUT = WS_WUT + 512 * 64 * 2;
constexpr size_t WS_GUT = WS_AUT + 512 * 64 * 2;
constexpr size_t WS_VDT = WS_GUT + 512 * 128 * 2;
constexpr size_t WS_VUT = WS_VDT + 32 * 512 * 2;
constexpr size_t WS_LWA = WS_VUT + 512 * 32 * 2;
constexpr size_t WS_LWX = WS_LWA + 8 * 64 * 64 * 2;
constexpr size_t WS_SMALL_END = WS_LWX + 8 * 64 * 64 * 2;
static_assert(WS_WDN + (size_t)D * FF * 2 <= WS_WIN && WS_SMALL_END <= 32 * MiB, "weight map");
constexpr size_t WS_VF = 32 * MiB;
constexpr size_t WS_XN = 48 * MiB;
constexpr size_t WS_BS = 80 * MiB;
constexpr size_t WS_AGG = 81 * MiB;
constexpr size_t WS_GG = 82 * MiB;
constexpr size_t WS_LOC = 98 * MiB;
constexpr size_t WS_H = WS_LOC;
constexpr size_t WS_PA = WS_LOC;
constexpr size_t WS_PL = WS_LOC + 56 * MiB;
constexpr size_t WS_SP = WS_LOC + 88 * MiB;
constexpr size_t WS_SQ = WS_SP + 16 * MiB;
constexpr size_t WS_SR = WS_SQ + 16 * MiB;
constexpr size_t WS_SY = WS_SR + 16 * MiB;
constexpr size_t WS_HC = WS_LOC;
constexpr size_t WS_HL = WS_LOC + 16 * MiB;
constexpr size_t WS_AP = WS_LOC + 32 * MiB;
constexpr size_t WS_OA = WS_SP;
constexpr size_t WS_OB = WS_SQ;
constexpr size_t WS_G = WS_LOC;
constexpr size_t WS_Y = WS_SR;
constexpr size_t WS_END = WS_SY + 16 * MiB;
static_assert(WS_END <= 256 * MiB && WS_H + (size_t)M * FF * 2 <= 256 * MiB && WS_G + (size_t)M * NGT * 2 <= WS_SP, "d_ws map");
constexpr int CW_BAR = 1024;

constexpr int SLOT = 8192;
constexpr int LDS_WORK = 18 * SLOT;
constexpr int MISC_OFF = LDS_WORK;
constexpr int TAB_OFF = MISC_OFF + 256;
constexpr int LDS_BYTES = LDS_WORK + 1024;

#define GAS __attribute__((address_space(1)))
#define LAS __attribute__((address_space(3)))
typedef unsigned short bf16;
typedef unsigned v4u __attribute__((ext_vector_type(4)));
typedef unsigned v2u __attribute__((ext_vector_type(2)));
typedef float f32x4 __attribute__((ext_vector_type(4)));
typedef short bf16x8 __attribute__((ext_vector_type(8)));
typedef GAS unsigned gu32;
typedef LAS unsigned char* lptr;
#define RLX_AGENT __ATOMIC_RELAXED, __HIP_MEMORY_SCOPE_AGENT
#define LDS_WAIT() asm volatile("s_waitcnt lgkmcnt(0)" ::: "memory")
#define VM_WAIT() asm volatile("s_waitcnt vmcnt(0)" ::: "memory")
__device__ __forceinline__ unsigned f2bf(float f) { unsigned u = __builtin_bit_cast(unsigned, f); return (u + 0x7fffu + ((u >> 16) & 1u)) >> 16; }
__device__ __forceinline__ unsigned pk2(float lo, float hi) { return f2bf(lo) | (f2bf(hi) << 16); }
__device__ __forceinline__ float bf2f(unsigned h) { return __uint_as_float(h << 16); }
__device__ __forceinline__ float bflo(unsigned w) { return __uint_as_float(w << 16); }
__device__ __forceinline__ float bfhi(unsigned w) { return __uint_as_float(w & 0xffff0000u); }
__device__ __forceinline__ float sigm(float x) { return __builtin_amdgcn_rcpf(1.0f + __expf(-x)); }
__device__ __forceinline__ float tanh_fast(float x) { const float e = __expf(2.0f * x); return 1.0f - 2.0f * __builtin_amdgcn_rcpf(e + 1.0f); }
__device__ __forceinline__ float bperm(float v, int src_lane) { return __int_as_float(__builtin_amdgcn_ds_bpermute(src_lane << 2, __float_as_int(v))); }
__device__ __forceinline__ float wave_sum(float v, int lane) {
#pragma unroll
    for (int o = 1; o < 64; o <<= 1) v += bperm(v, lane ^ o);
    return v;
}
__device__ __forceinline__ f32x4 mfma16(bf16x8 a, bf16x8 b, f32x4 c) { return __builtin_amdgcn_mfma_f32_16x16x32_bf16(a, b, c, 0, 0, 0); }

__device__ __forceinline__ int sw_off(int r, int c) { return r * 128 + ((c << 1) ^ ((r & 7) << 4)); }
__device__ __forceinline__ bf16x8 lds_frag(lptr base, int row, int c8) { return *(const LAS bf16x8*)(base + sw_off(row, c8)); }
__device__ __forceinline__ void lds_st16(lptr base, int r, int c, float v) { *(LAS bf16*)(base + sw_off(r, c)) = (bf16)f2bf(v); }
__device__ __forceinline__ float lds_ld16(lptr base, int r, int c) { return bf2f(*(const LAS bf16*)(base + sw_off(r, c))); }
__device__ __forceinline__ void lds_st4(lptr base, int r, int c4, f32x4 v) { v2u w; w.x = pk2(v[0], v[1]); w.y = pk2(v[2], v[3]); *(LAS v2u*)(base + sw_off(r, c4)) = w; }
__device__ __forceinline__ f32x4 lds_ld4(lptr base, int r, int c4) { const v2u w = *(const LAS v2u*)(base + sw_off(r, c4)); return (f32x4){bflo(w.x), bfhi(w.x), bflo(w.y), bfhi(w.y)}; }
__device__ __forceinline__ bf16x8 gl_frag(const bf16* p) { return *(const GAS bf16x8*)p; }
__device__ __forceinline__ f32x4 gl_ld4(const bf16* p) { const v2u w = *(const GAS v2u*)p; return (f32x4){bflo(w.x), bfhi(w.x), bflo(w.y), bfhi(w.y)}; }
__device__ __forceinline__ void gl_st4(bf16* p, f32x4 v) { v2u w; w.x = pk2(v[0], v[1]); w.y = pk2(v[2], v[3]); *(GAS v2u*)p = w; }

template <bool SW>
__device__ __forceinline__ void mma64(f32x4 (&acc)[2], lptr A, lptr B, int mt, int ntb, int lane) {
    const int r16 = lane & 15, g = lane >> 4;
#pragma unroll
    for (int s = 0; s < 2; ++s) {
        const bf16x8 a = lds_frag(A, 16 * mt + r16, 32 * s + 8 * g);
#pragma unroll
        for (int q = 0; q < 2; ++q) {
            const bf16x8 b = lds_frag(B, 16 * (ntb + q) + r16, 32 * s + 8 * g);
            acc[q] = SW ? mfma16(b, a, acc[q]) : mfma16(a, b, acc[q]);
        }
    }
}
#define ZERO2(acc) do { acc[0] = (f32x4){0.f, 0.f, 0.f, 0.f}; acc[1] = (f32x4){0.f, 0.f, 0.f, 0.f}; } while (0)
#define WG_BAR() do { asm volatile("s_waitcnt vmcnt(0) lgkmcnt(0)" ::: "memory"); __builtin_amdgcn_s_barrier(); asm volatile("" ::: "memory"); } while (0)
#define XB_TMO      128
#define XB_XCNT(j)  (256  + 64 * (j))
#define XB_XSUB(j)  (1280 + 64 * (j))
#define XB_XGEN(j)  (2304 + 64 * (j))
#define XB_TOP      3328
#define XB_TOPGEN   3392
#define XCD_BAR_WORDS 3456
#define XB_SPIN_CAP (1u << 18)

__device__ __forceinline__ unsigned xb_ld(unsigned* p)              { return __hip_atomic_load(p, __ATOMIC_RELAXED, __HIP_MEMORY_SCOPE_AGENT); }
__device__ __forceinline__ unsigned xb_add(unsigned* p, unsigned v) { return __hip_atomic_fetch_add(p, v, __ATOMIC_RELAXED, __HIP_MEMORY_SCOPE_AGENT); }
__device__ __forceinline__ unsigned xb_xcc_id() { return (unsigned)__builtin_amdgcn_s_getreg((3 << 11) | 20) & 0xFu; }
#define XB_SPIN(cond, bar) do { unsigned _sp = 0; while (cond) { __builtin_amdgcn_s_sleep(1); \
    if ((++_sp & 255u) == 0u) { if (xb_ld(&(bar)[XB_TMO])) break; if (_sp > XB_SPIN_CAP) { atomicAdd(&(bar)[XB_TMO], 1u); break; } } } } while (0)

struct XcdBarrier {
    unsigned* bar; unsigned x;
    volatile LAS unsigned* st;
};

__device__ __forceinline__ XcdBarrier xcd_barrier_post(unsigned* bar, volatile LAS unsigned* st) {
    XcdBarrier b; b.bar = bar; b.x = xb_xcc_id(); b.st = st;
    if (threadIdx.x == 0) (void)xb_add(&bar[XB_XCNT(b.x)], 1u);
    return b;
}
__device__ __forceinline__ void xcd_barrier_complete(unsigned* bar, unsigned x, unsigned& nloc, unsigned& nx) {
    const unsigned G = gridDim.x * gridDim.y * gridDim.z;
    unsigned sum, cnt, mine, sp = 0u;
    for (;;) {
        sum = 0u; cnt = 0u; mine = 0u;
#pragma unroll
        for (unsigned j = 0; j < 16; ++j) { const unsigned c = xb_ld(&bar[XB_XCNT(j)]); sum += c; cnt += (c > 0u) ? 1u : 0u; mine = (j == x) ? c : mine; }
        if (sum == G) break;
        __builtin_amdgcn_s_sleep(1);
        if ((++sp & 255u) == 0u) { if (xb_ld(&bar[XB_TMO])) break; if (sp > XB_SPIN_CAP) { atomicAdd(&bar[XB_TMO], 1u); break; } }
    }
    nloc = mine > 0u ? mine : 1u; nx = cnt > 0u ? cnt : 1u;
}

__device__ __forceinline__ void xcd_barrier(const XcdBarrier& b) {
    asm volatile("s_waitcnt vmcnt(0)" ::: "memory");
    __syncthreads();
    if (threadIdx.x == 0) {
        unsigned* bar = b.bar;
        __builtin_amdgcn_s_waitcnt(0);
        unsigned nloc = b.st[0], nx = b.st[1];
        if (nloc == 0u) { xcd_barrier_complete(bar, b.x, nloc, nx); b.st[0] = nloc; b.st[1] = nx; }
        const unsigned old = xb_add(&bar[XB_XSUB(b.x)], 1u);
        const unsigned gen = old / nloc;
        if (old + 1u == (gen + 1u) * nloc) {
            __builtin_amdgcn_fence(__ATOMIC_RELEASE, "agent");
            asm volatile("s_waitcnt vmcnt(0)" ::: "memory");
            const unsigned og = xb_add(&bar[XB_TOP], 1u);
            const unsigned tg = og / nx;
            if (og + 1u == (tg + 1u) * nx) xb_add(&bar[XB_TOPGEN], 1u);
            else XB_SPIN(xb_ld(&bar[XB_TOPGEN]) == tg, bar);
            __builtin_amdgcn_fence(__ATOMIC_ACQUIRE, "agent");
            xb_add(&bar[XB_XGEN(b.x)], 1u);
            asm volatile("s_waitcnt vmcnt(0)" ::: "memory");
        } else {
            XB_SPIN(xb_ld(&bar[XB_XGEN(b.x)]) == gen, bar);
            __builtin_amdgcn_fence(__ATOMIC_ACQUIRE, "agent");
            asm volatile("s_waitcnt vmcnt(0)" ::: "memory");
        }
    }
    __syncthreads();
}
struct Ctx {
    lptr lds; int tid, lane, wave, vcu, G;
    unsigned char* ws; float* out;
};

#define INP(i) ((const float*)(const GAS float*)(*(const LAS unsigned long long*)(C.lds + TAB_OFF + 8 * (i))))
__device__ __forceinline__ void transpose_item(const float* W, int K, int N, bf16* WT, int row_off, LAS float* scr, int kb, int nb, int lane) {
    const int k0 = 64 * kb, n0 = 32 * nb;
#pragma unroll 8
    for (int i = 0; i < 32; ++i) { const int kk = 2 * i + (lane >> 5); scr[kk * 33 + (lane & 31)] = W[(size_t)(k0 + kk) * N + n0 + (lane & 31)]; }
    LDS_WAIT(); asm volatile("" ::: "memory");
    const int c = lane & 7;
#pragma unroll
    for (int j = 0; j < 4; ++j) { const int n = (lane >> 3) + 8 * j; const LAS float* s = scr + (8 * c) * 33 + n;
        v4u o; o.x = pk2(s[0 * 33], s[1 * 33]); o.y = pk2(s[2 * 33], s[3 * 33]); o.z = pk2(s[4 * 33], s[5 * 33]); o.w = pk2(s[6 * 33], s[7 * 33]);
        *(GAS v4u*)(WT + (size_t)(row_off + n0 + n) * K + k0 + 8 * c) = o; }
    LDS_WAIT(); asm volatile("" ::: "memory");
}
__device__ __forceinline__ void conv_ffn(const Ctx& C, int layer, int which, int hw, int NHW) {
    const float* wup = INP(which ? 4 : 2) + (size_t)layer * D * NUP; const float* wdn = INP(which ? 5 : 3) + (size_t)layer * FF * D;
    bf16* WUP = (bf16*)(C.ws + WS_WUP); bf16* WDN = (bf16*)(C.ws + WS_WDN);
    LAS float* scr = (LAS float*)(C.lds + C.wave * 16384);
    constexpr int I_UP = (D / 64) * (NUP / 32), I_DN = (FF / 64) * (D / 32);
    for (int it = hw; it < I_UP + I_DN; it += NHW) {
        if (it < I_UP) { const int nblk = NUP / 32, kb = it / nblk, nb = it % nblk, n0 = 32 * nb;
            const int j0 = n0 < FF ? n0 : n0 - FF; const int dst = (j0 / 128) * 256 + (j0 % 128) + (n0 < FF ? 0 : 128);
            transpose_item(wup, D, NUP, WUP, dst - n0, scr, kb, nb, C.lane); }
        else { const int r = it - I_UP, nblk = D / 32; transpose_item(wdn, FF, D, WDN, 0, scr, r / nblk, r % nblk, C.lane); }
    }
}
__device__ __forceinline__ void conv_mix(const Ctx& C, int layer, int hw, int NHW) {
    const float* win = INP(6) + (size_t)layer * D * WIN; const float* pa = INP(28) + (size_t)layer * RW * D; const float* pb = INP(29) + (size_t)layer * LW * D; const float* wo = INP(30) + (size_t)layer * D * D;
    LAS float* scr = (LAS float*)(C.lds + C.wave * 16384);
    constexpr int I_IN = (D / 64) * (WIN / 32), I_P = (RW / 64) * (D / 32), I_O = (D / 64) * (D / 32);
    for (int it = hw; it < I_IN + 2 * I_P + I_O; it += NHW) {
        int r = it;
        if (r < I_IN) { transpose_item(win, D, WIN, (bf16*)(C.ws + WS_WIN), 0, scr, r / (WIN / 32), r % (WIN / 32), C.lane); continue; } r -= I_IN;
        if (r < I_P) { transpose_item(pa, RW, D, (bf16*)(C.ws + WS_PAT), 0, scr, r / (D / 32), r % (D / 32), C.lane); continue; } r -= I_P;
        if (r < I_P) { transpose_item(pb, LW, D, (bf16*)(C.ws + WS_PBT), 0, scr, r / (D / 32), r % (D / 32), C.lane); continue; } r -= I_P;
        transpose_item(wo, D, D, (bf16*)(C.ws + WS_WOT), 0, scr, r / (D / 32), r % (D / 32), C.lane);
    }
    const float* w_up = INP(9) + (size_t)layer * 64 * RW; const float* a_up = INP(11) + (size_t)layer * 64 * RW; const float* g_up = INP(12) + (size_t)layer * 128 * RW;
    const float* lwa = INP(23) + (size_t)layer * 8 * 64 * 64; const float* lwx = INP(25) + (size_t)layer * 8 * 64 * 64;
    bf16* WUT = (bf16*)(C.ws + WS_WUT); bf16* AUT = (bf16*)(C.ws + WS_AUT); bf16* GUT = (bf16*)(C.ws + WS_GUT); bf16* VDT = (bf16*)(C.ws + WS_VDT); bf16* VUT = (bf16*)(C.ws + WS_VUT);
    bf16* LWA = (bf16*)(C.ws + WS_LWA); bf16* LWX = (bf16*)(C.ws + WS_LWX);
    const int gt = hw * 64 + C.lane, NT = NHW * 64;
    for (int i = gt; i < 512 * 64; i += NT) { const int n = i >> 6, k = i & 63; WUT[i] = (bf16)f2bf(w_up[k * RW + n]); AUT[i] = (bf16)f2bf(a_up[k * RW + n]); }
    for (int i = gt; i < 512 * 128; i += NT) { const int n = i >> 7, k = i & 127; GUT[i] = (bf16)f2bf(g_up[k * RW + n]); }
    for (int i = gt; i < 8 * 64 * 64; i += NT) { const int nb = i >> 12, e = (i >> 6) & 63, d = i & 63; LWA[i] = (bf16)f2bf(lwa[(nb * 64 + d) * 64 + e]); LWX[i] = (bf16)f2bf(lwx[(nb * 64 + d) * 64 + e]); }
    if (layer > 0) {
        const float* v_down = INP(19) + (size_t)(layer - 1) * RW * 32; const float* v_up = INP(20) + (size_t)(layer - 1) * 32 * RW;
        for (int i = gt; i < 32 * 512; i += NT) { const int n = i >> 9, k = i & 511; VDT[i] = (bf16)f2bf(v_down[k * 32 + n]); }
        for (int i = gt; i < 512 * 32; i += NT) { const int n = i >> 5, k = i & 31; VUT[i] = (bf16)f2bf(v_up[k * RW + n]); }
    }
}

__device__ __forceinline__ void norm_phase(const Ctx& C, const float* xin, const bf16* ho, const float* g_post, float scale, const float* g_pre, bf16* xn) {
    const int gw = C.vcu * NWAVES + C.wave, NGW = C.G * NWAVES;
    int zhi = DBG_ZHI;
#if DBG_CHECK || DBG_WCHECK
    if (!g_pre) { const unsigned cnt_ = __hip_atomic_load((unsigned*)(C.ws + WS_CTL + 32768), __ATOMIC_RELAXED, __HIP_MEMORY_SCOPE_AGENT); const float f = DBG_WCHECK ? 0.01f * (float)(cnt_ & 15u) : (__uint_as_float(cnt_) < 0.05f ? 0.f : (__uint_as_float(cnt_) < 0.5f ? 0.02f : 0.04f)); zhi = (int)(f * M); }
#endif
    for (int m = gw; m < M; m += NGW) {
        const GAS f32x4* xr = (const GAS f32x4*)(xin + (size_t)m * D) + C.lane;
        f32x4 v[4];
#pragma unroll
        for (int j = 0; j < 4; ++j) v[j] = xr[64 * j];
        if (ho) {
            f32x4 h[4]; float s = 0.f;
#pragma unroll
            for (int j = 0; j < 4; ++j) { h[j] = gl_ld4(ho + (size_t)m * D + 4 * C.lane + 256 * j); s += (h[j][0] * h[j][0] + h[j][1] * h[j][1]) + (h[j][2] * h[j][2] + h[j][3] * h[j][3]); }
            const float rs = scale * __builtin_amdgcn_rsqf(wave_sum(s, C.lane) * (1.f / D) + RMS_EPS);
#pragma unroll
            for (int j = 0; j < 4; ++j) { const f32x4 gp = *(const GAS f32x4*)(g_post + 4 * C.lane + 256 * j); v[j] = v[j] + h[j] * rs * gp; }
        }
        GAS f32x4* orow = (GAS f32x4*)(C.out + (size_t)m * D) + C.lane;
#pragma unroll
        for (int j = 0; j < 4; ++j) orow[64 * j] = (!g_pre && m >= DBG_ZLO && m < zhi) ? (f32x4){0.f, 0.f, 0.f, 0.f} : v[j];
        if (g_pre) {
            float s2 = 0.f;
#pragma unroll
            for (int j = 0; j < 4; ++j) s2 += (v[j][0] * v[j][0] + v[j][1] * v[j][1]) + (v[j][2] * v[j][2] + v[j][3] * v[j][3]);
            const float rs2 = __builtin_amdgcn_rsqf(wave_sum(s2, C.lane) * (1.f / D) + RMS_EPS);
#pragma unroll
            for (int j = 0; j < 4; ++j) { const f32x4 gp = *(const GAS f32x4*)(g_pre + 4 * C.lane + 256 * j); gl_st4(xn + (size_t)m * D + 4 * C.lane + 256 * j, v[j] * rs2 * gp); }
        }
    }
}


#if DBG_CHECK || DBG_WCHECK
#define DBGW(C) ((unsigned*)((C).ws + WS_CTL + 32768))
__device__ __forceinline__ void dbg_max(const Ctx& C, float v) { if (C.lane == 0) atomicMax(DBGW(C), __float_as_uint(v == v ? fminf(fabsf(v), 1.0f) : 1.0f)); }
__device__ __forceinline__ unsigned dbg_hash(unsigned x) { x ^= x >> 16; x *= 0x7feb352dU; x ^= x >> 15; x *= 0x846ca68bU; x ^= x >> 16; return x; }
__device__ __forceinline__ float dbg_dot(const Ctx& C, const bf16* a, const bf16* b, int K) { float s = 0.f; for (int k = C.lane; k < K; k += 64) s += bf2f(a[k]) * bf2f(b[k]); return wave_sum(s, C.lane); }
__device__ __forceinline__ float dbg_rel(float expv, float got) { return fabsf(expv - got) / (fabsf(expv) + 1.0f); }
#endif

#if DBG_SEQ
__device__ __forceinline__ float rdl(float v, int l) { return __int_as_float(__builtin_amdgcn_readlane(__float_as_int(v), l)); }
__device__ __forceinline__ void dbg_seq_rwkv(const Ctx& C, int layer, int bh) {
    const bf16* PA = (const bf16*)(C.ws + WS_PA); bf16* OA = (bf16*)(C.ws + WS_GG);
    const float* mu = INP(7) + (size_t)layer * WSH; const float* w_up = INP(9) + (size_t)layer * 64 * RW; const float* a_up = INP(11) + (size_t)layer * 64 * RW; const float* g_up = INP(12) + (size_t)layer * 128 * RW;
    const int lane = C.lane, b = bh >> 3, h = bh & 7, cg = 64 * h + lane;
    const float w0c = INP(8)[layer * RW + cg], a0c = INP(10)[layer * RW + cg], kkc = INP(13)[layer * RW + cg], kac = INP(14)[layer * RW + cg], rkc = INP(15)[layer * RW + cg];
    const float lnw = INP(16)[layer * RW + cg], lnb = INP(17)[layer * RW + cg];
    const float mur = mu[cg], muk = mu[RW + cg], muv = mu[2 * RW + cg], muw = mu[3 * RW + lane], mua = mu[3 * RW + 64 + lane], mug0 = mu[3 * RW + 128 + lane], mug1 = mu[3 * RW + 192 + lane];
    float S[64];
#pragma unroll
    for (int k = 0; k < 64; ++k) S[k] = 0.f;
    float pr = 0.f, pk = 0.f, pv = 0.f, pw = 0.f, pa = 0.f, pg0 = 0.f, pg1 = 0.f;
    for (int t = 0; t < T; ++t) {
        const size_t ro = (size_t)(b * T + t) * WSH;
        const float cr = bf2f(PA[ro + cg]), ck = bf2f(PA[ro + RW + cg]), cv = bf2f(PA[ro + 2 * RW + cg]);
        const float cw = bf2f(PA[ro + 3 * RW + lane]), ca = bf2f(PA[ro + 3 * RW + 64 + lane]), cg0 = bf2f(PA[ro + 3 * RW + 128 + lane]), cg1 = bf2f(PA[ro + 3 * RW + 192 + lane]);
        const float r = cr + mur * (pr - cr), kx = ck + muk * (pk - ck), v = cv + muv * (pv - cv);
        const float tw = tanhf(cw + muw * (pw - cw)), xa = ca + mua * (pa - ca), sg0 = 1.f / (1.f + expf(-(cg0 + mug0 * (pg0 - cg0)))), sg1 = 1.f / (1.f + expf(-(cg1 + mug1 * (pg1 - cg1))));
        pr = cr; pk = ck; pv = cv; pw = cw; pa = ca; pg0 = cg0; pg1 = cg1;
        float wl = 0.f, ap = 0.f, gg = 0.f;
#pragma unroll 4
        for (int k = 0; k < 64; ++k) { wl += rdl(tw, k) * w_up[k * RW + cg]; ap += rdl(xa, k) * a_up[k * RW + cg]; gg += rdl(sg0, k) * g_up[k * RW + cg] + rdl(sg1, k) * g_up[(64 + k) * RW + cg]; }
        const float z = w0c + wl, wlog = -log1pf(expf(-z)) - 0.5f, wd = expf(-expf(wlog));
        const float ag = 1.f / (1.f + expf(-(a0c + ap)));
        const float kkr = kx * kkc, n2 = wave_sum(kkr * kkr, lane), kk = kkr / fmaxf(sqrtf(n2), 1e-12f);
        const float k2 = kx * (1.f + (ag - 1.f) * kac), av = -kk, bv = kk * ag;
        float sa = 0.f;
#pragma unroll
        for (int k = 0; k < 64; ++k) sa += S[k] * rdl(av, k);
        float y = 0.f;
#pragma unroll
        for (int k = 0; k < 64; ++k) { S[k] = S[k] * rdl(wd, k) + sa * rdl(bv, k) + v * rdl(k2, k); y += S[k] * rdl(r, k); }
        const float mean = wave_sum(y, lane) * (1.f / 64.f), d = y - mean, var = wave_sum(d * d, lane) * (1.f / 64.f);
        const float bon = wave_sum(r * k2 * rkc, lane);
        OA[(size_t)(b * T + t) * RW + cg] = (bf16)f2bf((d * (1.f / sqrtf(var + GN_EPS)) * lnw + lnb + bon * v) * gg);
    }
}
__device__ __forceinline__ void dbg_seq_lru(const Ctx& C, int layer, int bn) {
    const bf16* PL = (const bf16*)(C.ws + WS_PL); bf16* OB = (bf16*)(C.ws + WS_OB);
    const int lane = C.lane, b = bn >> 3, n = bn & 7, ch = 64 * n + lane;
    const float* cw = INP(21) + (size_t)layer * 4 * LW; const float cb = INP(22)[layer * LW + ch];
    const float* wa = INP(23) + ((size_t)layer * 8 + n) * 4096; const float* wx = INP(25) + ((size_t)layer * 8 + n) * 4096;
    const float bac = INP(24)[layer * LW + ch], bxc = INP(26)[layer * LW + ch], lam = INP(27)[layer * LW + ch];
    const float c0 = cw[ch], c1 = cw[LW + ch], c2 = cw[2 * LW + ch], c3 = cw[3 * LW + ch], spl = log1pf(expf(-lam));
    float x1 = 0.f, x2 = 0.f, x3 = 0.f, hst = 0.f;
    for (int t = 0; t < T; ++t) {
        const size_t ro = (size_t)(b * T + t) * 1024;
        const float x0 = bf2f(PL[ro + ch]), gt = bf2f(PL[ro + LW + ch]);
        const float xb = cb + c0 * x3 + c1 * x2 + c2 * x1 + c3 * x0; x3 = x2; x2 = x1; x1 = x0;
        float sa = 0.f, sx = 0.f;
#pragma unroll 4
        for (int d = 0; d < 64; ++d) { const float xd = rdl(xb, d); sa += xd * wa[d * 64 + lane]; sx += xd * wx[d * 64 + lane]; }
        const float ga = 1.f / (1.f + expf(-(sa + bac))), gx = 1.f / (1.f + expf(-(sx + bxc)));
        const float la = -8.0f * ga * spl, a = expf(la); float mult = sqrtf(-expm1f(2.f * la)); if (t == 0) mult = 1.f;
        hst = a * hst + xb * gx * mult;
        const float u = 0.7978845608028654f * (gt + 0.044715f * gt * gt * gt);
        OB[(size_t)(b * T + t) * LW + ch] = (bf16)f2bf(hst * 0.5f * gt * (1.f + tanhf(u)));
    }
}
#endif

#if 1
__device__ __forceinline__ float naive_dot(const bf16* a, const bf16* b, int K) {
    float s0 = 0.f, s1 = 0.f, s2 = 0.f, s3 = 0.f;
    for (int k = 0; k < K; k += 8) { const v4u av = *(const GAS v4u*)(a + k), bv = *(const GAS v4u*)(b + k);
        s0 += bflo(av.x) * bflo(bv.x) + bfhi(av.x) * bfhi(bv.x); s1 += bflo(av.y) * bflo(bv.y) + bfhi(av.y) * bfhi(bv.y);
        s2 += bflo(av.z) * bflo(bv.z) + bfhi(av.z) * bfhi(bv.z); s3 += bflo(av.w) * bflo(bv.w) + bfhi(av.w) * bfhi(bv.w); }
    return (s0 + s1) + (s2 + s3);
}
#endif
__device__ __forceinline__ float shifted(const bf16* PA, int m, int col, float mu, bool first) {
    const float p = bf2f(PA[(size_t)m * WSH + col]); const float pp = first ? 0.f : bf2f(PA[(size_t)(m - 1) * WSH + col]);
    return p + mu * (pp - p);
}
enum { SL_XL0 = 0, SL_XL1 = 1, SL_MISC = 2, SL_WL = 3, SL_AP = 4, SL_VM = 5, SL_MRB = 6, SL_AT = 7, SL_ATT = 8, SL_RT = 9, SL_BT = 10, SL_KT = 11, SL_BHT = 12, SL_KHT = 13, SL_VT = 14, SL_TA = 15, SL_MRK = 16, SL_XT = 17 };
enum { SL_L = SL_WL, SL_LT = SL_AP, SL_LAK = SL_VM, SL_L2 = SL_AT, SL_L2T = SL_BT, SL_TB = SL_KT, SL_WUT = SL_WL, SL_U0T = SL_AP, SL_XL2 = SL_WL, SL_XL3 = SL_AP };
#define SLOTP(i) (C.lds + (i) * SLOT)

__device__ __forceinline__ void prepA_phase(const Ctx& C, int layer) {
    const bf16* PA = (const bf16*)(C.ws + WS_PA);
    bf16* VF = (bf16*)(C.ws + WS_VF); bf16* GG = (bf16*)(C.ws + WS_GG); float* BS = (float*)(C.ws + WS_BS);
    bf16* SP = (bf16*)(C.ws + WS_SP); bf16* SQ = (bf16*)(C.ws + WS_SQ); bf16* SR = (bf16*)(C.ws + WS_SR); bf16* SY = (bf16*)(C.ws + WS_SY);
    const bf16* WUT = (const bf16*)(C.ws + WS_WUT); const bf16* AUT = (const bf16*)(C.ws + WS_AUT); const bf16* GUT = (const bf16*)(C.ws + WS_GUT);
    const bf16* VDT = (const bf16*)(C.ws + WS_VDT); const bf16* VUT = (const bf16*)(C.ws + WS_VUT);
    const float* mu = INP(7) + (size_t)layer * WSH;
    const float* w0 = INP(8) + layer * RW; const float* a0 = INP(10) + layer * RW; const float* k_k = INP(13) + layer * RW; const float* k_a = INP(14) + layer * RW; const float* r_k = INP(15) + layer * RW;
    const float* v0 = INP(18);
    const int lane = C.lane, wave = C.wave, tid = C.tid, r16 = lane & 15, g = lane >> 4;
    LAS float* segtot = (LAS float*)(SLOTP(SL_MISC) + 4096);
    LAS float* gC = (LAS float*)(SLOTP(SL_MISC) + 6144);
    lptr VDm = SLOTP(SL_MISC);

    for (int cidx = C.vcu; cidx < NCHUNK; cidx += C.G) {
        const int m0 = cidx * 64; const bool seq0 = (cidx % NCH_SEQ) == 0;
        for (int idx = tid; idx < 64 * 256; idx += NWAVES * 64) {
            const int t = idx >> 8, cc = idx & 255, col = 3 * RW + cc;
            const float val = shifted(PA, m0 + t, col, mu[col], seq0 && t == 0);
            const float f = cc < 64 ? tanh_fast(val) : (cc < 128 ? val : sigm(val));
            const int sl = cc < 64 ? SL_XL0 : (cc < 128 ? SL_XL1 : (cc < 192 ? SL_XL2 : SL_XL3));
            lds_st16(SLOTP(sl), t, cc & 63, f);
        }
        WG_BAR();
        { const int mt = wave & 3, nt0 = (wave >> 2) * 16;
          bf16x8 a[4];
#pragma unroll
          for (int s = 0; s < 4; ++s) a[s] = lds_frag(SLOTP(s < 2 ? SL_XL2 : SL_XL3), 16 * mt + r16, 32 * (s & 1) + 8 * g);
          for (int nt = nt0; nt < nt0 + 16; ++nt) {
              f32x4 acc = (f32x4){0.f, 0.f, 0.f, 0.f};
#pragma unroll
              for (int s = 0; s < 4; ++s) { const bf16x8 b = gl_frag(GUT + (size_t)(16 * nt + r16) * 128 + 32 * s + 8 * g); acc = mfma16(b, a[s], acc); }
              gl_st4(GG + (size_t)(m0 + 16 * mt + r16) * RW + 16 * nt + 4 * g, acc);
          } }
        WG_BAR();
        if (layer > 0) {
            for (int idx = tid; idx < 64 * 512; idx += NWAVES * 64) {
                const int t = idx >> 9, c = idx & 511, col = 2 * RW + c;
                lds_st16(SLOTP(5 + (c >> 6)), t, c & 63, shifted(PA, m0 + t, col, mu[col], seq0 && t == 0));
            }
            WG_BAR();
            { const int mt = wave & 3, nt = wave >> 2;
              f32x4 acc = (f32x4){0.f, 0.f, 0.f, 0.f};
              for (int blk = 0; blk < 8; ++blk)
#pragma unroll
                  for (int s = 0; s < 2; ++s) { const bf16x8 a = lds_frag(SLOTP(5 + blk), 16 * mt + r16, 32 * s + 8 * g);
                      const bf16x8 b = gl_frag(VDT + (size_t)(16 * nt + r16) * 512 + 64 * blk + 32 * s + 8 * g); acc = mfma16(a, b, acc); }
              WG_BAR();
#pragma unroll
              for (int i = 0; i < 4; ++i) *(LAS bf16*)(VDm + (16 * mt + 4 * g + i) * 64 + (16 * nt + r16) * 2) = (bf16)f2bf(acc[i]);
            }
            WG_BAR();
        }
        for (int h = 0; h < NH; ++h) {
            int lane_l = C.lane; asm volatile("" : "+v"(lane_l));
            const int lane = lane_l, r16 = lane & 15, g = lane >> 4;
            const int c0 = 64 * h, ch = lane, cg = c0 + ch, t0 = 8 * wave;
            float rr[8], kr[8], vr[8];
            { const float mur = mu[cg], muk = mu[RW + cg], muv = mu[2 * RW + cg];
              float pr = (seq0 && t0 == 0) ? 0.f : bf2f(PA[(size_t)(m0 + t0 - 1) * WSH + cg]);
              float pk = (seq0 && t0 == 0) ? 0.f : bf2f(PA[(size_t)(m0 + t0 - 1) * WSH + RW + cg]);
              float pv = (seq0 && t0 == 0) ? 0.f : bf2f(PA[(size_t)(m0 + t0 - 1) * WSH + 2 * RW + cg]);
#pragma unroll
              for (int u = 0; u < 8; ++u) { const size_t ro = (size_t)(m0 + t0 + u) * WSH;
                  const float cr = bf2f(PA[ro + cg]), ck = bf2f(PA[ro + RW + cg]), cv = bf2f(PA[ro + 2 * RW + cg]);
                  rr[u] = cr + mur * (pr - cr); kr[u] = ck + muk * (pk - ck); vr[u] = cv + muv * (pv - cv); pr = cr; pk = ck; pv = cv; } }
            { const int mt = wave >> 1, ntb = (wave & 1) * 2;
              f32x4 aw[2], aa[2]; ZERO2(aw); ZERO2(aa);
#pragma unroll
              for (int s = 0; s < 2; ++s) { const bf16x8 x0 = lds_frag(SLOTP(SL_XL0), 16 * mt + r16, 32 * s + 8 * g), x1 = lds_frag(SLOTP(SL_XL1), 16 * mt + r16, 32 * s + 8 * g);
#pragma unroll
                  for (int q = 0; q < 2; ++q) { const size_t ro = (size_t)(c0 + 16 * (ntb + q) + r16) * 64 + 32 * s + 8 * g;
                      aw[q] = mfma16(x0, gl_frag(WUT + ro), aw[q]); aa[q] = mfma16(x1, gl_frag(AUT + ro), aa[q]); } }
#pragma unroll
              for (int q = 0; q < 2; ++q)
#pragma unroll
                  for (int i = 0; i < 4; ++i) { lds_st16(SLOTP(SL_WL), 16 * mt + 4 * g + i, 16 * (ntb + q) + r16, aw[q][i]); lds_st16(SLOTP(SL_AP), 16 * mt + 4 * g + i, 16 * (ntb + q) + r16, aa[q][i]); }
              if (layer > 0) {
                  const bf16x8 xv = *(const LAS bf16x8*)(VDm + (16 * mt + r16) * 64 + 16 * g);
#pragma unroll
                  for (int q = 0; q < 2; ++q) { f32x4 av = (f32x4){0.f, 0.f, 0.f, 0.f}; av = mfma16(xv, gl_frag(VUT + (size_t)(c0 + 16 * (ntb + q) + r16) * 32 + 8 * g), av);
#pragma unroll
                      for (int i = 0; i < 4; ++i) lds_st16(SLOTP(SL_VM), 16 * mt + 4 * g + i, 16 * (ntb + q) + r16, av[i]); }
              } }
            WG_BAR();
            float lw[8], cs[8];
            { const float w0c = w0[cg]; float run = 0.f;
#pragma unroll
              for (int u = 0; u < 8; ++u) {
                  const float z = w0c + lds_ld16(SLOTP(SL_WL), t0 + u, ch);
                  const float sp = fmaxf(-z, 0.f) + __logf(1.0f + __expf(-fabsf(z)));
                  lw[u] = -__expf(-sp - 0.5f); run += lw[u]; cs[u] = run; }
              segtot[wave * 64 + ch] = run; }
            WG_BAR();
            { float pre = 0.f, tot = 0.f;
#pragma unroll
              for (int s = 0; s < 8; ++s) { const float x = segtot[s * 64 + ch]; tot += x; pre += (s < wave) ? x : 0.f; }
              if (wave == 0) gC[ch] = __expf(tot);
              const float a0c = a0[cg], kkc = k_k[cg], kac = k_a[cg], rkc = r_k[cg]; const float v0c = layer > 0 ? v0[cg] : 0.f;
              float atr[8], bhr[8], khr[8], v2[8];
#pragma unroll
              for (int u = 0; u < 8; ++u) { const int t = t0 + u;
                  const float ag = sigm(a0c + lds_ld16(SLOTP(SL_AP), t, ch));
                  const float kkr = kr[u] * kkc; const float n2 = wave_sum(kkr * kkr, lane);
                  const float kk = kkr / fmaxf(sqrtf(n2), 1e-12f);
                  const float k2 = kr[u] * (1.0f + (ag - 1.0f) * kac), av = -kk, bv = kk * ag;
                  float vv = vr[u];
                  if (layer > 0) { const float vf = bf2f(VF[(size_t)(m0 + t) * RW + cg]); vv = vv + (vf - vv) * sigm(v0c + lds_ld16(SLOTP(SL_VM), t, ch)); }
                  const unsigned vb = f2bf(vv); v2[u] = bf2f(vb); VF[(size_t)(m0 + t) * RW + cg] = (bf16)vb;
                  const float bsum = wave_sum(rr[u] * k2 * rkc, lane);
                  if (lane == 0) BS[(size_t)(m0 + t) * NH + h] = bsum;
                  const float c = pre + cs[u];
                  const float ec = __expf(c), em = __expf(c - lw[u]), en = __expf(-c), eh = __expf(tot - c);
                  atr[u] = av * em; bhr[u] = bv * eh; khr[u] = k2 * eh;
                  lds_st16(SLOTP(SL_AT), t, ch, atr[u]); lds_st16(SLOTP(SL_RT), t, ch, rr[u] * ec); lds_st16(SLOTP(SL_BT), t, ch, bv * en); lds_st16(SLOTP(SL_KT), t, ch, k2 * en); }
              v4u w;
              w.x = pk2(atr[0], atr[1]); w.y = pk2(atr[2], atr[3]); w.z = pk2(atr[4], atr[5]); w.w = pk2(atr[6], atr[7]); *(LAS v4u*)(SLOTP(SL_ATT) + sw_off(ch, t0)) = w;
              w.x = pk2(bhr[0], bhr[1]); w.y = pk2(bhr[2], bhr[3]); w.z = pk2(bhr[4], bhr[5]); w.w = pk2(bhr[6], bhr[7]); *(LAS v4u*)(SLOTP(SL_BHT) + sw_off(ch, t0)) = w;
              w.x = pk2(khr[0], khr[1]); w.y = pk2(khr[2], khr[3]); w.z = pk2(khr[4], khr[5]); w.w = pk2(khr[6], khr[7]); *(LAS v4u*)(SLOTP(SL_KHT) + sw_off(ch, t0)) = w;
              w.x = pk2(v2[0], v2[1]); w.y = pk2(v2[2], v2[3]); w.z = pk2(v2[4], v2[5]); w.w = pk2(v2[6], v2[7]); *(LAS v4u*)(SLOTP(SL_VT) + sw_off(ch, t0)) = w; }
            WG_BAR();
            const int mt = wave >> 1, ntb = (wave & 1) * 2;
            { f32x4 ab[2], ak[2], rb[2], rk[2]; ZERO2(ab); ZERO2(ak); ZERO2(rb); ZERO2(rk);
              mma64<false>(ab, SLOTP(SL_AT), SLOTP(SL_BT), mt, ntb, lane); mma64<false>(ak, SLOTP(SL_AT), SLOTP(SL_KT), mt, ntb, lane);
              mma64<false>(rb, SLOTP(SL_RT), SLOTP(SL_BT), mt, ntb, lane); mma64<false>(rk, SLOTP(SL_RT), SLOTP(SL_KT), mt, ntb, lane);
#pragma unroll
              for (int q = 0; q < 2; ++q) { const int col = 16 * (ntb + q) + r16; f32x4 l4, k4, b4, r4;
#pragma unroll
                  for (int i = 0; i < 4; ++i) { const int row = 16 * mt + 4 * g + i;
                      l4[i] = row > col ? ab[q][i] : 0.f; k4[i] = row > col ? ak[q][i] : 0.f; b4[i] = row >= col ? rb[q][i] : 0.f; r4[i] = row >= col ? rk[q][i] : 0.f;
                      lds_st16(SLOTP(SL_L), row, col, l4[i]); lds_st16(SLOTP(SL_TA), row, col, l4[i] + (row == col ? 1.f : 0.f));
                      lds_st16(SLOTP(SL_LAK), row, col, k4[i]); lds_st16(SLOTP(SL_MRB), row, col, b4[i]); lds_st16(SLOTP(SL_MRK), row, col, r4[i]); }
                  lds_st4(SLOTP(SL_LT), col, 16 * mt + 4 * g, l4); } }
            WG_BAR();
#define SQUARE(src, srcT, dst, dstT) do { f32x4 sq[2]; ZERO2(sq); mma64<false>(sq, SLOTP(src), SLOTP(srcT), mt, ntb, lane); \
              _Pragma("unroll") for (int q = 0; q < 2; ++q) { const int col = 16 * (ntb + q) + r16; \
                  _Pragma("unroll") for (int i = 0; i < 4; ++i) lds_st16(SLOTP(dst), 16 * mt + 4 * g + i, col, sq[q][i]); \
                  lds_st4(SLOTP(dstT), col, 16 * mt + 4 * g, sq[q]); } } while (0)
#define TUPDATE(tsrc, lT, tdst) do { f32x4 tu[2]; \
              _Pragma("unroll") for (int q = 0; q < 2; ++q) tu[q] = lds_ld4(SLOTP(tsrc), 16 * mt + r16, 16 * (ntb + q) + 4 * g); \
              mma64<true>(tu, SLOTP(tsrc), SLOTP(lT), mt, ntb, lane); \
              _Pragma("unroll") for (int q = 0; q < 2; ++q) lds_st4(SLOTP(tdst), 16 * mt + r16, 16 * (ntb + q) + 4 * g, tu[q]); } while (0)
            { SQUARE(SL_L, SL_LT, SL_L2, SL_L2T);
              f32x4 x[2]; ZERO2(x); mma64<false>(x, SLOTP(SL_LAK), SLOTP(SL_VT), mt, ntb, lane);
#pragma unroll
              for (int q = 0; q < 2; ++q) lds_st4(SLOTP(SL_XT), 16 * (ntb + q) + r16, 16 * mt + 4 * g, x[q]); }
            WG_BAR();
            TUPDATE(SL_TA, SL_L2T, SL_TB); SQUARE(SL_L2, SL_L2T, SL_L, SL_LT);
            WG_BAR();
            TUPDATE(SL_TB, SL_LT, SL_TA); SQUARE(SL_L, SL_LT, SL_L2, SL_L2T);
            WG_BAR();
            TUPDATE(SL_TA, SL_L2T, SL_TB); SQUARE(SL_L2, SL_L2T, SL_L, SL_LT);
            WG_BAR();
            TUPDATE(SL_TB, SL_LT, SL_TA); SQUARE(SL_L, SL_LT, SL_L2, SL_L2T);
            WG_BAR();
            TUPDATE(SL_TA, SL_L2T, SL_TB);
            WG_BAR();
            { f32x4 wu[2], u0[2]; ZERO2(wu); ZERO2(u0);
              mma64<false>(wu, SLOTP(SL_TB), SLOTP(SL_ATT), mt, ntb, lane); mma64<false>(u0, SLOTP(SL_TB), SLOTP(SL_XT), mt, ntb, lane);
#pragma unroll
              for (int q = 0; q < 2; ++q) { lds_st4(SLOTP(SL_WUT), 16 * (ntb + q) + r16, 16 * mt + 4 * g, wu[q]); lds_st4(SLOTP(SL_U0T), 16 * (ntb + q) + r16, 16 * mt + 4 * g, u0[q]); } }
            WG_BAR();
            { const size_t cb = ((size_t)cidx * NH + h) * 4096;
              f32x4 re[2], y0[2], pp[2], qq[2]; ZERO2(y0); ZERO2(pp); ZERO2(qq);
#pragma unroll
              for (int q = 0; q < 2; ++q) re[q] = lds_ld4(SLOTP(SL_RT), 16 * mt + r16, 16 * (ntb + q) + 4 * g);
              mma64<true>(re, SLOTP(SL_MRB), SLOTP(SL_WUT), mt, ntb, lane);
              mma64<true>(y0, SLOTP(SL_MRB), SLOTP(SL_U0T), mt, ntb, lane); mma64<true>(y0, SLOTP(SL_MRK), SLOTP(SL_VT), mt, ntb, lane);
              mma64<true>(pp, SLOTP(SL_BHT), SLOTP(SL_WUT), mt, ntb, lane);
              mma64<false>(qq, SLOTP(SL_BHT), SLOTP(SL_U0T), mt, ntb, lane); mma64<false>(qq, SLOTP(SL_KHT), SLOTP(SL_VT), mt, ntb, lane);
              const int row = 16 * mt + r16;
#pragma unroll
              for (int q = 0; q < 2; ++q) { const int cq = 16 * (ntb + q) + 4 * g;
#pragma unroll
                  for (int i = 0; i < 4; ++i) pp[q][i] += (row == cq + i) ? gC[row] : 0.f;
                  gl_st4(SR + cb + row * 64 + cq, re[q]); gl_st4(SY + cb + row * 64 + cq, y0[q]); gl_st4(SP + cb + row * 64 + cq, pp[q]);
                  gl_st4(SQ + cb + (16 * (ntb + q) + r16) * 64 + 16 * mt + 4 * g, qq[q]); } }
            WG_BAR();
        }
    }
}

__device__ __forceinline__ void stageB_wave(const Ctx& C, int bh, int vs) {
    const bf16* SP = (const bf16*)(C.ws + WS_SP); const bf16* SQ = (const bf16*)(C.ws + WS_SQ); bf16* HC = (bf16*)(C.ws + WS_HC);
    const int lane = C.lane, r16 = lane & 15, g = lane >> 4, b = bh >> 3, h = bh & 7, v0 = 16 * vs;
    f32x4 acc[4];
#pragma unroll
    for (int k = 0; k < 4; ++k) acc[k] = (f32x4){0.f, 0.f, 0.f, 0.f};
    v2u pa[4][2][2], pq[4];
    { const size_t cb = ((size_t)(b * NCH_SEQ) * NH + h) * 4096;
#pragma unroll
      for (int mt = 0; mt < 4; ++mt) { pq[mt] = *(const GAS v2u*)(SQ + cb + (v0 + r16) * 64 + 16 * mt + 4 * g);
#pragma unroll
          for (int s = 0; s < 2; ++s)
#pragma unroll
              for (int e = 0; e < 2; ++e) pa[mt][s][e] = *(const GAS v2u*)(SP + cb + (16 * mt + r16) * 64 + 32 * s + 16 * e + 4 * g); } }
    for (int c = 0; c < NCH_SEQ; ++c) {
        const size_t cb = ((size_t)(b * NCH_SEQ + c) * NH + h) * 4096;
        v2u na[4][2][2], nq[4];
        { const int cn = c + 1 < NCH_SEQ ? c + 1 : c; const size_t nb = ((size_t)(b * NCH_SEQ + cn) * NH + h) * 4096;
#pragma unroll
          for (int mt = 0; mt < 4; ++mt) { nq[mt] = *(const GAS v2u*)(SQ + nb + (v0 + r16) * 64 + 16 * mt + 4 * g);
#pragma unroll
              for (int s = 0; s < 2; ++s)
#pragma unroll
                  for (int e = 0; e < 2; ++e) na[mt][s][e] = *(const GAS v2u*)(SP + nb + (16 * mt + r16) * 64 + 32 * s + 16 * e + 4 * g); } }
        v2u hb[4];
#pragma unroll
        for (int kt = 0; kt < 4; ++kt) { hb[kt].x = pk2(acc[kt][0], acc[kt][1]); hb[kt].y = pk2(acc[kt][2], acc[kt][3]); *(GAS v2u*)(HC + cb + (v0 + r16) * 64 + 16 * kt + 4 * g) = hb[kt]; }
        bf16x8 bfr[2];
#pragma unroll
        for (int s = 0; s < 2; ++s) { const v4u w = (v4u){hb[2 * s].x, hb[2 * s].y, hb[2 * s + 1].x, hb[2 * s + 1].y}; bfr[s] = __builtin_bit_cast(bf16x8, w); }
#pragma unroll
        for (int mt = 0; mt < 4; ++mt) {
            f32x4 a = (f32x4){bflo(pq[mt].x), bfhi(pq[mt].x), bflo(pq[mt].y), bfhi(pq[mt].y)};
#pragma unroll
            for (int s = 0; s < 2; ++s) { const v4u w = (v4u){pa[mt][s][0].x, pa[mt][s][0].y, pa[mt][s][1].x, pa[mt][s][1].y}; a = mfma16(__builtin_bit_cast(bf16x8, w), bfr[s], a); }
            acc[mt] = a;
        }
#pragma unroll
        for (int mt = 0; mt < 4; ++mt) { pq[mt] = nq[mt];
#pragma unroll
            for (int s = 0; s < 2; ++s)
#pragma unroll
                for (int e = 0; e < 2; ++e) pa[mt][s][e] = na[mt][s][e]; }
    }
}

__device__ __forceinline__ void stageC_wave(const Ctx& C, int layer, int ci) {
    const bf16* SR = (const bf16*)(C.ws + WS_SR); const bf16* SY = (const bf16*)(C.ws + WS_SY); const bf16* HC = (const bf16*)(C.ws + WS_HC);
    const bf16* VF = (const bf16*)(C.ws + WS_VF); const bf16* GG = (const bf16*)(C.ws + WS_GG); const float* BS = (const float*)(C.ws + WS_BS); bf16* OA = (bf16*)(C.ws + WS_OA);
    const float* ln_w = INP(16) + layer * RW; const float* ln_b = INP(17) + layer * RW;
    const int lane = C.lane, r16 = lane & 15, g = lane >> 4, cidx = ci >> 3, h = ci & 7, m0 = cidx * 64;
    const size_t cb = (size_t)ci * 4096;
    bf16x8 hb[4][2];
#pragma unroll
    for (int nt = 0; nt < 4; ++nt)
#pragma unroll
        for (int s = 0; s < 2; ++s) hb[nt][s] = gl_frag(HC + cb + (16 * nt + r16) * 64 + 32 * s + 8 * g);
    f32x4 lw4[4], lb4[4];
#pragma unroll
    for (int nt = 0; nt < 4; ++nt) { lw4[nt] = *(const GAS f32x4*)(ln_w + 64 * h + 16 * nt + 4 * g); lb4[nt] = *(const GAS f32x4*)(ln_b + 64 * h + 16 * nt + 4 * g); }
#pragma unroll
    for (int mt = 0; mt < 4; ++mt) {
        const int t = 16 * mt + r16;
        f32x4 y[4];
#pragma unroll
        for (int nt = 0; nt < 4; ++nt) y[nt] = gl_ld4(SY + cb + t * 64 + 16 * nt + 4 * g);
#pragma unroll
        for (int s = 0; s < 2; ++s) { const bf16x8 a = gl_frag(SR + cb + t * 64 + 32 * s + 8 * g);
#pragma unroll
            for (int nt = 0; nt < 4; ++nt) { if (!DBG_NO_STATE) y[nt] = mfma16(hb[nt][s], a, y[nt]); } }
        float s1 = 0.f;
#pragma unroll
        for (int nt = 0; nt < 4; ++nt) s1 += (y[nt][0] + y[nt][1]) + (y[nt][2] + y[nt][3]);
        s1 += bperm(s1, lane ^ 16); s1 += bperm(s1, lane ^ 32);
        const float mean = s1 * (1.f / 64.f); float s2 = 0.f;
#pragma unroll
        for (int nt = 0; nt < 4; ++nt) { y[nt] = y[nt] - mean; s2 += (y[nt][0] * y[nt][0] + y[nt][1] * y[nt][1]) + (y[nt][2] * y[nt][2] + y[nt][3] * y[nt][3]); }
        s2 += bperm(s2, lane ^ 16); s2 += bperm(s2, lane ^ 32);
        const float rstd = __builtin_amdgcn_rsqf(s2 * (1.f / 64.f) + GN_EPS);
        const float bs = BS[(size_t)(m0 + t) * NH + h];
#pragma unroll
        for (int nt = 0; nt < 4; ++nt) { const size_t go = (size_t)(m0 + t) * RW + 64 * h + 16 * nt + 4 * g;
            const f32x4 vv = gl_ld4(VF + go), gg = gl_ld4(GG + go);
            f32x4 ov = (y[nt] * rstd * lw4[nt] + lb4[nt] + bs * vv) * gg;
            if ((DBG_ZERO_OA >> layer) & 1) ov = (f32x4){0.f, 0.f, 0.f, 0.f};
            gl_st4(OA + go, ov); }
    }
}

__device__ __forceinline__ void lru_tile_wave(const Ctx& C, int layer, int item) {
    const bf16* PL = (const bf16*)(C.ws + WS_PL); bf16* HL = (bf16*)(C.ws + WS_HL); bf16* AP = (bf16*)(C.ws + WS_AP); float* AGG = (float*)(C.ws + WS_AGG);
    const bf16* LWA = (const bf16*)(C.ws + WS_LWA); const bf16* LWX = (const bf16*)(C.ws + WS_LWX);
    const float* cw = INP(21) + (size_t)layer * 4 * LW; const float* cbias = INP(22) + layer * LW;
    const float* ba = INP(24) + layer * LW; const float* bx = INP(26) + layer * LW; const float* lam = INP(27) + layer * LW;
    const int lane = C.lane, r16 = lane & 15, g = lane >> 4, cidx = item >> 3, n = item & 7, m0 = cidx * 64; const bool seq0 = (cidx % NCH_SEQ) == 0;
    bf16x8 af[4][2];
#pragma unroll
    for (int s = 0; s < 2; ++s) {
        const int chb = 64 * n + 32 * s + 8 * g;
        float w[4][8], cb8[8];
#pragma unroll
        for (int jj = 0; jj < 4; ++jj) { const f32x4 w0 = *(const GAS f32x4*)(cw + jj * LW + chb), w1 = *(const GAS f32x4*)(cw + jj * LW + chb + 4);
#pragma unroll
            for (int e = 0; e < 4; ++e) { w[jj][e] = w0[e]; w[jj][4 + e] = w1[e]; } }
        { const f32x4 c0 = *(const GAS f32x4*)(cbias + chb), c1 = *(const GAS f32x4*)(cbias + chb + 4);
#pragma unroll
          for (int e = 0; e < 4; ++e) { cb8[e] = c0[e]; cb8[4 + e] = c1[e]; } }
#pragma unroll
        for (int mt = 0; mt < 4; ++mt) {
            float xb[8];
#pragma unroll
            for (int e = 0; e < 8; ++e) xb[e] = cb8[e];
#pragma unroll
            for (int jj = 0; jj < 4; ++jj) { const int tl = 16 * mt + r16 - 3 + jj;
                v4u xv = (v4u){0u, 0u, 0u, 0u};
                if (!(seq0 && tl < 0)) xv = *(const GAS v4u*)(PL + (size_t)(m0 + tl) * 1024 + chb);
                xb[0] += w[jj][0] * bflo(xv.x); xb[1] += w[jj][1] * bfhi(xv.x); xb[2] += w[jj][2] * bflo(xv.y); xb[3] += w[jj][3] * bfhi(xv.y);
                xb[4] += w[jj][4] * bflo(xv.z); xb[5] += w[jj][5] * bfhi(xv.z); xb[6] += w[jj][6] * bflo(xv.w); xb[7] += w[jj][7] * bfhi(xv.w); }
            const v4u pw = (v4u){pk2(xb[0], xb[1]), pk2(xb[2], xb[3]), pk2(xb[4], xb[5]), pk2(xb[6], xb[7])};
            af[mt][s] = __builtin_bit_cast(bf16x8, pw);
        }
    }
#pragma unroll 1
    for (int nt = 0; nt < 4; ++nt) {
        const int co = 64 * n + 16 * nt + r16;
        f32x4 ga[4], gx[4], xi[4];
#pragma unroll
        for (int mt = 0; mt < 4; ++mt) { ga[mt] = (f32x4){0.f, 0.f, 0.f, 0.f}; gx[mt] = ga[mt]; xi[mt] = ga[mt]; }
#pragma unroll
        for (int s = 0; s < 2; ++s) {
            const bf16x8 wa = gl_frag(LWA + (size_t)(n * 64 + 16 * nt + r16) * 64 + 32 * s + 8 * g), wx = gl_frag(LWX + (size_t)(n * 64 + 16 * nt + r16) * 64 + 32 * s + 8 * g);
            bf16x8 idf;
#pragma unroll
            for (int j = 0; j < 8; ++j) idf[j] = (32 * s + 8 * g + j == 16 * nt + r16) ? (short)0x3F80 : (short)0;
#pragma unroll
            for (int mt = 0; mt < 4; ++mt) { ga[mt] = mfma16(af[mt][s], wa, ga[mt]); gx[mt] = mfma16(af[mt][s], wx, gx[mt]); xi[mt] = mfma16(af[mt][s], idf, xi[mt]); }
        }
        const float bac = ba[co], bxc = bx[co], lm = lam[co];
        const float spl = fmaxf(-lm, 0.f) + __logf(1.0f + __expf(-fabsf(lm)));
        float cA = 1.f, cB = 0.f;
        const int up16 = lane >= 16 ? lane - 16 : lane, up32 = lane >= 32 ? lane - 32 : lane;
#pragma unroll
        for (int mt = 0; mt < 4; ++mt) {
            float Ai[4], Bi[4];
#pragma unroll
            for (int i = 0; i < 4; ++i) {
                const int tl = 16 * mt + 4 * g + i;
                const float gav = sigm(ga[mt][i] + bac), gxv = sigm(gx[mt][i] + bxc);
                const float la = -8.0f * gav * spl, a = __expf(la);
                float mult = sqrtf(fmaxf(1.0f - __expf(2.0f * la), 0.f)); if (seq0 && tl == 0) mult = 1.0f;
                const float bb = xi[mt][i] * gxv * mult;
                if (i == 0) { Ai[0] = a; Bi[0] = bb; } else { Ai[i] = Ai[i - 1] * a; Bi[i] = a * Bi[i - 1] + bb; }
            }
            float IA = Ai[3], IB = Bi[3];
            { const float pA = bperm(IA, up16), pB = bperm(IB, up16); if (g >= 1) { IB = IA * pB + IB; IA = pA * IA; } }
            { const float pA = bperm(IA, up32), pB = bperm(IB, up32); if (g >= 2) { IB = IA * pB + IB; IA = pA * IA; } }
            float EA = bperm(IA, up16), EB = bperm(IB, up16); if (g == 0) { EA = 1.f; EB = 0.f; }
            const float CA = cA * EA, CB = EA * cB + EB;
#pragma unroll
            for (int i = 0; i < 4; ++i) { const size_t go = (size_t)(m0 + 16 * mt + 4 * g + i) * LW + co;
                HL[go] = (bf16)f2bf(Ai[i] * CB + Bi[i]); AP[go] = (bf16)f2bf(Ai[i] * CA); }
            const float TA = bperm(IA, 48 + r16), TB = bperm(IB, 48 + r16);
            cB = TA * cB + TB; cA = cA * TA;
        }
        if (g == 0) { AGG[((size_t)cidx * LW + co) * 2] = cA; AGG[((size_t)cidx * LW + co) * 2 + 1] = cB; }
    }
}
__device__ __forceinline__ float gelu_tanh(float x) { const float u = 0.7978845608028654f * (x + 0.044715f * x * x * x); return 0.5f * x * (1.0f + tanh_fast(u)); }
__device__ __forceinline__ void lru_carry_wave(const Ctx& C, int layer, int item) {
    const bf16* PL = (const bf16*)(C.ws + WS_PL); const bf16* HL = (const bf16*)(C.ws + WS_HL); const bf16* AP = (const bf16*)(C.ws + WS_AP); const float* AGG = (const float*)(C.ws + WS_AGG); bf16* OB = (bf16*)(C.ws + WS_OB);
    const int cidx = item >> 3, n = item & 7, ch = 64 * n + C.lane, m0 = cidx * 64, cs = cidx % NCH_SEQ, c_first = cidx - cs;
    float hin = 0.f;
    for (int j = 0; j < cs; ++j) { const float* ap_ = AGG + ((size_t)(c_first + j) * LW + ch) * 2; hin = ap_[0] * hin + ap_[1]; }
#pragma unroll 8
    for (int t = 0; t < 64; ++t) { const size_t go = (size_t)(m0 + t) * LW + ch;
        const float hv = bf2f(HL[go]) + (DBG_NO_CARRY ? 0.f : bf2f(AP[go]) * hin); const float gt = bf2f(PL[(size_t)(m0 + t) * 1024 + LW + ch]);
        OB[go] = ((DBG_ZERO_OB >> layer) & 1) ? (bf16)0 : (bf16)f2bf(hv * gelu_tanh(gt)); }
}
#ifndef PH_MASK
#define PH_MASK 0xffff
#endif
#define PHM(i) ((PH_MASK >> (i)) & 1)
struct Args { const float* in[31]; float* out; unsigned char* ws; int ph_lo, ph_hi; };
#ifndef MK_SP2
#define MK_SP2 true
#endif
__global__ void __launch_bounds__(NWAVES * 64, 2) hybrid_fwd(Args args) {
    extern __shared__ __attribute__((aligned(16))) unsigned char lds_raw[];
    __builtin_amdgcn_fence(__ATOMIC_ACQUIRE, "agent"); asm volatile("s_waitcnt vmcnt(0)" ::: "memory");
    const lptr ldsb = (lptr)lds_raw; const int tid0 = threadIdx.x;
    constexpr int G = GRID; int vcu; { const int bx = blockIdx.x; vcu = (G % 8 == 0) ? (bx % 8) * (G / 8) + bx / 8 : bx; }
    volatile LAS unsigned* MISC = (volatile LAS unsigned*)(ldsb + MISC_OFF);
    for (int u = tid0; u < (LDS_BYTES - MISC_OFF) / 4; u += NWAVES * 64) MISC[u] = 0u;
    __syncthreads();
    if (tid0 < 31) *(LAS unsigned long long*)(ldsb + TAB_OFF + 8 * tid0) = (unsigned long long)args.in[tid0];
    __syncthreads();
    XcdBarrier bar; bar.bar = (unsigned*)(args.ws + WS_CTL) + CW_BAR; bar.x = 0; bar.st = nullptr;
    const int lo = args.ph_lo, hi = args.ph_hi;
    if (hi - lo > 1) bar = xcd_barrier_post((unsigned*)(args.ws + WS_CTL) + CW_BAR, MISC + 8);

    for (int p = lo; p < hi; ++p) {
        int tidp = threadIdx.x; asm volatile("" : "+v"(tidp));
        Ctx C; C.lds = ldsb; C.tid = tidp; C.lane = tidp & 63; C.wave = __builtin_amdgcn_readfirstlane(tidp >> 6); C.vcu = vcu; C.G = G; C.ws = args.ws; C.out = args.out;
        int bxp = blockIdx.x; asm volatile("" : "+s"(bxp));
        const int gw = C.vcu * NWAVES + C.wave, NGW = C.G * NWAVES;
        bf16* XN = (bf16*)(C.ws + WS_XN);
#if DBG_SEQ
        if (p == 152) { const v4u* src = (const v4u*)(C.ws + WS_GG); v4u* dst = (v4u*)(C.ws + WS_OA); for (int i = blockIdx.x * 512 + C.tid; i < M * RW / 8; i += GRID * 512) dst[i] = src[i]; continue; }
        if (p == 150 || p == 151) { const int layer = DBG_LAYER; if (blockIdx.x < 16 && C.wave == 0) { if (p == 150) dbg_seq_rwkv(C, layer, blockIdx.x); else dbg_seq_lru(C, layer, blockIdx.x); } continue; }
#endif
#if DBG_WCHECK
        if (p == 160) {
            unsigned bad = 0u; const int gt_ = blockIdx.x * 512 + C.tid;
            const bf16* WUP = (const bf16*)(C.ws + WS_WUP); const bf16* WDN = (const bf16*)(C.ws + WS_WDN); const bf16* WINb = (const bf16*)(C.ws + WS_WIN);
            const bf16* PAT = (const bf16*)(C.ws + WS_PAT); const bf16* PBT = (const bf16*)(C.ws + WS_PBT); const bf16* WOT = (const bf16*)(C.ws + WS_WOT);
            for (int sI = gt_; sI < (1 << 20); sI += GRID * 512) { const unsigned hh = dbg_hash(sI * 2 + 1), h2 = dbg_hash(sI * 2 + 2);
                { const int k = hh % D, j = h2 % FF; const int rg = (j / 128) * 256 + j % 128;
                  if (WUP[(size_t)rg * D + k] != (bf16)f2bf(INP(2)[(size_t)k * NUP + j])) bad |= 1u; if (WUP[(size_t)(rg + 128) * D + k] != (bf16)f2bf(INP(2)[(size_t)k * NUP + FF + j])) bad |= 1u; }
                { const int k = hh % FF, n = h2 % D; if (WDN[(size_t)n * FF + k] != (bf16)f2bf(INP(3)[(size_t)k * D + n])) bad |= 2u; }
                { const int k = hh % D, n = h2 % WIN; if (WINb[(size_t)n * D + k] != (bf16)f2bf(INP(6)[(size_t)k * WIN + n])) bad |= 4u; }
                { const int k = hh % RW, n = h2 % D; if (PAT[(size_t)n * RW + k] != (bf16)f2bf(INP(28)[(size_t)k * D + n])) bad |= 4u; if (PBT[(size_t)n * LW + k] != (bf16)f2bf(INP(29)[(size_t)k * D + n])) bad |= 4u; }
                { const int k = hh % D, n = h2 % D; if (WOT[(size_t)n * D + k] != (bf16)f2bf(INP(30)[(size_t)k * D + n])) bad |= 4u; }
            }
            if (bad) atomicOr(DBGW(C), bad);
            continue; }
#endif
#if DBG_SPLIT8
        if (p == 170 || p == 171 || p == 172) {
            if (p == 170 && DBG_NAIVEG) { const bf16* W = (const bf16*)(C.ws + WS_WIN) + (size_t)NAL * D; bf16* Gp = (bf16*)(C.ws + WS_G);
                for (size_t i = (size_t)blockIdx.x * 512 + C.tid; i < (size_t)M * NGT; i += (size_t)GRID * 512) { const int m = (int)(i / NGT), n = (int)(i % NGT); Gp[i] = (bf16)f2bf(sigm(naive_dot(XN + (size_t)m * D, W + (size_t)n * D, D))); }
                continue; }
            if (p == 170) { pg8::Gemm gm{XN, (const bf16*)(C.ws + WS_WIN) + (size_t)NAL * D, M, NGT, D}; pg8::StaticOrder S; S.init(M, NGT, C.G, bxp);
                pg8::EpiMap<DBG_SIGLATE ? 0 : 1> E{(bf16*)(C.ws + WS_G), NGT, 1 << 20, (bf16*)(C.ws + WS_G), NGT};
                pg8::gemm_phase<pg8::EpiMap<DBG_SIGLATE ? 0 : 1>, pg8::StaticOrder, true, MK_SP2>(C.lds, gm, S, E); }
            if (p == 171) { pg8::Gemm gm{(const bf16*)(C.ws + WS_OA), (const bf16*)(C.ws + WS_PAT), M, D, RW}; pg8::StaticOrder S; S.init(M, D, C.G, bxp);
                pg8::EpiGateMerge<0> E{(bf16*)(C.ws + WS_Y), D, (const bf16*)(C.ws + WS_G), NGT, 0};
                pg8::gemm_phase<pg8::EpiGateMerge<0>, pg8::StaticOrder, true, MK_SP2>(C.lds, gm, S, E); }
            if (p == 172) { pg8::Gemm gm{(const bf16*)(C.ws + WS_OB), (const bf16*)(C.ws + WS_PBT), M, D, LW}; pg8::StaticOrder S; S.init(M, D, C.G, bxp);
                pg8::EpiGateMerge<1> E{(bf16*)(C.ws + WS_Y), D, (const bf16*)(C.ws + WS_G), NGT, D};
                pg8::gemm_phase<pg8::EpiGateMerge<1>, pg8::StaticOrder, true, MK_SP2>(C.lds, gm, S, E); }
            continue; }
#endif
        if (p == 200) {
            const bf16* src = (const bf16*)(C.ws + DBG_DUMP_OFF);
            for (size_t i = (size_t)(blockIdx.x * 512 + C.tid); i < (size_t)M * D; i += (size_t)GRID * 512) C.out[i] = bf2f(src[i]);
            continue; }
        const bool dbg_only = p >= 100; const int pp_ = dbg_only ? p - 100 : p;
        const int layer = pp_ / PH_PER_LAYER, k = pp_ % PH_PER_LAYER;
#if DBG_CHECK
        if (dbg_only && layer == DBG_LAYER) { const int NS = 8192;
            if ((DBG_CHECK & 2) && k == 2) { const bf16* H = (const bf16*)(C.ws + WS_H); const bf16* W = (const bf16*)(C.ws + WS_WUP);
                for (int sI = gw; sI < NS; sI += NGW) { const unsigned hh = dbg_hash(sI * 2 + 1); const int m = hh % M, j = (hh >> 14) % FF; const int rg = (j / 128) * 256 + j % 128;
                    const float gt = dbg_dot(C, XN + (size_t)m * D, W + (size_t)rg * D, D), up = dbg_dot(C, XN + (size_t)m * D, W + (size_t)(rg + 128) * D, D);
                    dbg_max(C, dbg_rel(gt * sigm(gt) * up, bf2f(H[(size_t)m * FF + j]))); } }
            if ((DBG_CHECK & 4) && k == 3) { const bf16* H = (const bf16*)(C.ws + WS_H); const bf16* W = (const bf16*)(C.ws + WS_WDN);
                for (int sI = gw; sI < NS; sI += NGW) { const unsigned hh = dbg_hash(sI * 2 + 1); const int m = hh % M, n = (hh >> 14) % D;
                    dbg_max(C, dbg_rel(dbg_dot(C, H + (size_t)m * FF, W + (size_t)n * FF, FF), bf2f(XN[(size_t)m * D + n]))); } }
            if ((DBG_CHECK & 8) && k == 5) { const bf16* W = (const bf16*)(C.ws + WS_WIN); const bf16* PAp = (const bf16*)(C.ws + WS_PA); const bf16* PLp = (const bf16*)(C.ws + WS_PL);
                for (int sI = gw; sI < NS; sI += NGW) { const unsigned hh = dbg_hash(sI * 2 + 1); const int m = hh % M, n = (hh >> 14) % NAL;
                    const float got = n < WSH ? bf2f(PAp[(size_t)m * WSH + n]) : bf2f(PLp[(size_t)m * 1024 + n - WSH]);
                    dbg_max(C, dbg_rel(dbg_dot(C, XN + (size_t)m * D, W + (size_t)n * D, D), got)); } }
            if ((DBG_CHECK & 16) && k == 9) { const bf16* W = (const bf16*)(C.ws + WS_WIN) + (size_t)NAL * D; const bf16* Yp = (const bf16*)(C.ws + WS_Y);
                const bf16* OAp = (const bf16*)(C.ws + WS_OA); const bf16* OBp = (const bf16*)(C.ws + WS_OB); const bf16* PAT = (const bf16*)(C.ws + WS_PAT); const bf16* PBT = (const bf16*)(C.ws + WS_PBT);
                for (int sI = gw; sI < NS; sI += NGW) { const unsigned hh = dbg_hash(sI * 2 + 1); const int m = hh % M, n = (hh >> 14) % D;
                    const float gr = sigm(dbg_dot(C, XN + (size_t)m * D, W + (size_t)n * D, D)), gl = sigm(dbg_dot(C, XN + (size_t)m * D, W + (size_t)(D + n) * D, D));
                    const float ya = dbg_dot(C, OAp + (size_t)m * RW, PAT + (size_t)n * RW, RW), yb = dbg_dot(C, OBp + (size_t)m * LW, PBT + (size_t)n * LW, LW);
                    const bf16* Gp = (const bf16*)(C.ws + WS_G);
                    if (DBG_SUB == 0) dbg_max(C, dbg_rel(gr * ya + gl * yb, bf2f(Yp[(size_t)m * D + n])));
                    if (DBG_SUB == 1) dbg_max(C, dbg_rel(gr, bf2f(Gp[(size_t)m * NGT + n])));
                    if (DBG_SUB == 2) dbg_max(C, dbg_rel(gl, bf2f(Gp[(size_t)m * NGT + D + n])));
                    if (DBG_SUB == 3) dbg_max(C, dbg_rel(bf2f(Gp[(size_t)m * NGT + n]) * ya + bf2f(Gp[(size_t)m * NGT + D + n]) * yb, bf2f(Yp[(size_t)m * D + n]))); } }
            if ((DBG_CHECK & 32) && k == 10) { const bf16* W = (const bf16*)(C.ws + WS_WOT); const bf16* Yp = (const bf16*)(C.ws + WS_Y);
                for (int sI = gw; sI < NS; sI += NGW) { const unsigned hh = dbg_hash(sI * 2 + 1); const int m = hh % M, n = (hh >> 14) % D;
                    dbg_max(C, dbg_rel(dbg_dot(C, Yp + (size_t)m * D, W + (size_t)n * D, D), bf2f(XN[(size_t)m * D + n]))); } }
            VM_WAIT(); __syncthreads();
        }
        if (dbg_only) continue;
#endif
#if DBG_NAIVE
        if (!dbg_only && ((DBG_NLAYERS >> layer) & 1)) { const size_t gt_ = (size_t)blockIdx.x * 512 + C.tid, NTH = (size_t)GRID * 512; bool done_ = false;
            if ((DBG_NAIVE & 16) && (k == 1 || k == 11)) { bf16* H = (bf16*)(C.ws + WS_H); const bf16* W = (const bf16*)(C.ws + WS_WUP);
                for (size_t i = gt_; i < (size_t)M * FF; i += NTH) { const int m = (int)(i / FF), j = (int)(i % FF); const int rg = (j / 128) * 256 + j % 128;
                    const float gt = naive_dot(XN + (size_t)m * D, W + (size_t)rg * D, D), up = naive_dot(XN + (size_t)m * D, W + (size_t)(rg + 128) * D, D); H[i] = (bf16)f2bf(gt * sigm(gt) * up); } done_ = true; }
            if ((DBG_NAIVE & 1) && (k == 2 || k == 12)) { const bf16* H = (const bf16*)(C.ws + WS_H); const bf16* W = (const bf16*)(C.ws + WS_WDN);
                for (size_t i = gt_; i < (size_t)M * D; i += NTH) { const int m = (int)(i / D), n = (int)(i % D); XN[i] = (bf16)f2bf(naive_dot(H + (size_t)m * FF, W + (size_t)n * FF, FF)); } done_ = true; }
            if ((DBG_NAIVE & 2) && k == 4) { const bf16* W = (const bf16*)(C.ws + WS_WIN); bf16* PAp = (bf16*)(C.ws + WS_PA); bf16* PLp = (bf16*)(C.ws + WS_PL);
                for (size_t i = gt_; i < (size_t)M * NAL; i += NTH) { const int m = (int)(i / NAL), n = (int)(i % NAL); const unsigned v = f2bf(naive_dot(XN + (size_t)m * D, W + (size_t)n * D, D));
                    if (n < WSH) PAp[(size_t)m * WSH + n] = (bf16)v; else PLp[(size_t)m * 1024 + n - WSH] = (bf16)v; } done_ = true; }
            if ((DBG_NAIVE & 4) && k == 8) { const bf16* W = (const bf16*)(C.ws + WS_WIN) + (size_t)NAL * D; bf16* Yp = (bf16*)(C.ws + WS_Y);
                const bf16* OAp = (const bf16*)(C.ws + WS_OA); const bf16* OBp = (const bf16*)(C.ws + WS_OB); const bf16* PAT = (const bf16*)(C.ws + WS_PAT); const bf16* PBT = (const bf16*)(C.ws + WS_PBT);
                for (size_t i = gt_; i < (size_t)M * D; i += NTH) { const int m = (int)(i / D), n = (int)(i % D);
                    const float gr = sigm(naive_dot(XN + (size_t)m * D, W + (size_t)n * D, D)), gl = sigm(naive_dot(XN + (size_t)m * D, W + (size_t)(D + n) * D, D));
                    Yp[i] = (bf16)f2bf(gr * naive_dot(OAp + (size_t)m * RW, PAT + (size_t)n * RW, RW) + gl * naive_dot(OBp + (size_t)m * LW, PBT + (size_t)n * LW, LW)); } done_ = true; }
            if ((DBG_NAIVE & 8) && k == 9) { const bf16* W = (const bf16*)(C.ws + WS_WOT); const bf16* Yp = (const bf16*)(C.ws + WS_Y);
                for (size_t i = gt_; i < (size_t)M * D; i += NTH) { const int m = (int)(i / D), n = (int)(i % D); XN[i] = (bf16)f2bf(naive_dot(Yp + (size_t)m * D, W + (size_t)n * D, D)); } done_ = true; }
            if (done_) continue;
        }
#endif
        if (k == 0 && PHM(0)) {
#if DBG_CHECK || DBG_WCHECK
            if (layer == 0 && blockIdx.x == 0 && C.tid == 0) *DBGW(C) = 0u;
#endif
            if (layer == 0) { conv_ffn(C, 0, 0, gw, NGW); conv_mix(C, 0, gw, NGW); norm_phase(C, INP(0), nullptr, nullptr, 0.f, INP(1), XN); }
        } else if ((k == 1 || k == 11) && PHM(1)) {
            pg8::Gemm gm{XN, (const bf16*)(C.ws + WS_WUP), M, NUP, D}; pg8::StaticOrder S; S.init(M, NUP, C.G, bxp);
            pg8::EpiSwiglu E{(bf16*)(C.ws + WS_H), FF};
            pg8::gemm_phase<pg8::EpiSwiglu, pg8::StaticOrder, true, MK_SP2>(C.lds, gm, S, E);
        } else if ((k == 2 || k == 12) && PHM(2)) {
            pg8::Gemm gm{(const bf16*)(C.ws + WS_H), (const bf16*)(C.ws + WS_WDN), M, D, FF}; pg8::StaticOrder S; S.init(M, D, C.G, bxp);
            pg8::EpiMap<0> E{XN, D, 1 << 20, XN, D};
            pg8::gemm_phase<pg8::EpiMap<0>, pg8::StaticOrder, true, MK_SP2>(C.lds, gm, S, E);
        } else if ((k == 3 || k == 10 || k == 13) && PHM(3)) {
            const int gi = (k == 3) ? 1 : (k == 10 ? 3 : 5); const float* ng = INP(1) + (size_t)layer * 6 * D;
            const float* gpre = (k == 13) ? (layer + 1 < 2 ? INP(1) + (size_t)(layer + 1) * 6 * D : nullptr) : ng + (gi + 1) * D;
            norm_phase(C, C.out, XN, ng + gi * D, (k == 10) ? 1.0f : 0.5f, gpre, XN);
            if (k == 13 && layer == 0) { conv_ffn(C, 1, 0, gw, NGW); conv_mix(C, 1, gw, NGW); }
        } else if (k == 4 && PHM(4)) {
            pg8::Gemm gm{XN, (const bf16*)(C.ws + WS_WIN), M, NAL, D}; pg8::StaticOrder S; S.init(M, NAL, C.G, bxp);
            pg8::EpiMap<0> E{(bf16*)(C.ws + WS_PA), WSH, WSH / 256, (bf16*)(C.ws + WS_PL), 1024};
            pg8::gemm_phase<pg8::EpiMap<0>, pg8::StaticOrder, true, MK_SP2>(C.lds, gm, S, E);
        } else if (k == 5 && PHM(5)) {
            prepA_phase(C, layer);
        } else if (k == 6 && PHM(6)) {
            if (C.vcu < 64) { if (C.wave == 0) stageB_wave(C, C.vcu >> 2, C.vcu & 3); }
            else { const int hw = (C.vcu - 64) * NWAVES + C.wave, NHW = (C.G - 64) * NWAVES;
                for (int it = hw; it < NCHUNK * 8; it += NHW) lru_tile_wave(C, layer, it);
                conv_ffn(C, layer, 1, hw, NHW); }
        } else if (k == 7 && PHM(7)) {
            for (int it = gw; it < NCHUNK * NH; it += NGW) stageC_wave(C, layer, it);
            for (int it = gw; it < NCHUNK * 8; it += NGW) lru_carry_wave(C, layer, it);
        } else if (k == 8 && PHM(8)) {
            pg8::StaticOrder S; S.init(M, D, C.G, bxp); pg8::Unit base;
            for (int i = 0; S.next(i, base); ++i) {
                { pg8::Gemm gm{XN, (const bf16*)(C.ws + WS_WIN) + (size_t)NAL * D, M, NGT, D}; pg8::PairOrder PO{base};
                  pg8::EpiMap<1> E{(bf16*)(C.ws + WS_G), NGT, 1 << 20, (bf16*)(C.ws + WS_G), NGT};
                  pg8::gemm_phase<pg8::EpiMap<1>, pg8::PairOrder, true, MK_SP2>(C.lds, gm, PO, E); }
                { pg8::Gemm gm{(const bf16*)(C.ws + WS_OA), (const bf16*)(C.ws + WS_PAT), M, D, RW}; pg8::OneUnit OU{base};
                  pg8::EpiGateMerge<0> E{(bf16*)(C.ws + WS_Y), D, (const bf16*)(C.ws + WS_G), NGT, 0};
                  pg8::gemm_phase<pg8::EpiGateMerge<0>, pg8::OneUnit, true, MK_SP2>(C.lds, gm, OU, E); }
                { pg8::Gemm gm{(const bf16*)(C.ws + WS_OB), (const bf16*)(C.ws + WS_PBT), M, D, LW}; pg8::OneUnit OU{base};
                  pg8::EpiGateMerge<1> E{(bf16*)(C.ws + WS_Y), D, (const bf16*)(C.ws + WS_G), NGT, D};
                  pg8::gemm_phase<pg8::EpiGateMerge<1>, pg8::OneUnit, true, MK_SP2>(C.lds, gm, OU, E); }
            }
        } else if (k == 9 && PHM(9)) {
            pg8::Gemm gm{(const bf16*)(C.ws + WS_Y), (const bf16*)(C.ws + WS_WOT), M, D, D}; pg8::StaticOrder S; S.init(M, D, C.G, bxp);
            pg8::EpiMap<0> E{XN, D, 1 << 20, XN, D};
            pg8::gemm_phase<pg8::EpiMap<0>, pg8::StaticOrder, true, MK_SP2>(C.lds, gm, S, E);
        }
        if (p + 1 < hi) xcd_barrier(bar);
    }
    asm volatile("s_waitcnt vmcnt(0)" ::: "memory"); __builtin_amdgcn_fence(__ATOMIC_RELEASE, "agent"); asm volatile("s_waitcnt vmcnt(0)" ::: "memory");
}

#ifndef MK_ONE_LAUNCH
#define MK_ONE_LAUNCH 0
#endif
extern "C" void kernel_launch(void* const* d_in, const int* in_sizes, int n_in, void* d_out, int out_size, void* d_ws, size_t ws_size, hipStream_t stream) {
    static int grid = 0;
    if (grid == 0) {
        if (n_in != 31 || in_sizes[0] != M * D || out_size != M * D || ws_size < WS_END) { fprintf(stderr, "kernel_launch: unexpected problem (n_in %d, in0 %d, out %d, ws %zu); nothing launched\n", n_in, n_in > 0 ? in_sizes[0] : -1, out_size, ws_size); grid = -1; return; }
        int dev = 0, cus = 0;
        if (hipGetDevice(&dev) != hipSuccess || hipDeviceGetAttribute(&cus, hipDeviceAttributeMultiprocessorCount, dev) != hipSuccess) { grid = -1; return; }
        if (hipFuncSetAttribute((const void*)hybrid_fwd, hipFuncAttributeMaxDynamicSharedMemorySize, LDS_BYTES) != hipSuccess) { fprintf(stderr, "kernel_launch: hipFuncSetAttribute failed\n"); grid = -1; return; }
        (void)hipGetLastError();
        if (cus != GRID) fprintf(stderr, "kernel_launch: built for %d CUs, device has %d\n", GRID, cus);
        grid = GRID;
    }
    if (grid < 0) return;
    (void)hipMemsetAsync((char*)d_ws + WS_CTL, 0, CTL_ZERO_BYTES, stream);
    Args a{};
    for (int i = 0; i < 31; ++i) a.in[i] = (const float*)d_in[i];
    a.out = (float*)d_out; a.ws = (unsigned char*)d_ws;
#if MK_ONE_LAUNCH
    a.ph_lo = 0; a.ph_hi = N_PHASES;
    hipLaunchKernelGGL(hybrid_fwd, dim3(grid), dim3(NWAVES * 64), LDS_BYTES, stream, a);
#else
    for (int p = 0; p < DBG_LAST_PHASE; ++p) {
        if (p == PH_PER_LAYER) continue;
#if DBG_CHECK
        a.ph_lo = 100 + p; a.ph_hi = 101 + p;
        hipLaunchKernelGGL(hybrid_fwd, dim3(grid), dim3(NWAVES * 64), LDS_BYTES, stream, a);
#endif
#if DBG_SPLIT8
        if (p % PH_PER_LAYER == 8) { for (int q = 170; q < 173; ++q) { a.ph_lo = q; a.ph_hi = q + 1; hipLaunchKernelGGL(hybrid_fwd, dim3(grid), dim3(NWAVES * 64), LDS_BYTES, stream, a); } continue; }
#endif
        a.ph_lo = p; a.ph_hi = p + 1;
        hipLaunchKernelGGL(hybrid_fwd, dim3(grid), dim3(NWAVES * 64), LDS_BYTES, stream, a);
#if DBG_WCHECK
        if (p == 0) { a.ph_lo = 160; a.ph_hi = 161; hipLaunchKernelGGL(hybrid_fwd, dim3(grid), dim3(NWAVES * 64), LDS_BYTES, stream, a); }
#endif
#if DBG_SEQ
        if (p == DBG_LAYER * PH_PER_LAYER + 5 && (DBG_SEQ & 1)) { a.ph_lo = 150; a.ph_hi = 151; hipLaunchKernelGGL(hybrid_fwd, dim3(grid), dim3(NWAVES * 64), LDS_BYTES, stream, a); }
        if (p == DBG_LAYER * PH_PER_LAYER + 7 && (DBG_SEQ & 1)) { a.ph_lo = 152; a.ph_hi = 153; hipLaunchKernelGGL(hybrid_fwd, dim3(grid), dim3(NWAVES * 64), LDS_BYTES, stream, a); }
        if (p == DBG_LAYER * PH_PER_LAYER + 7 && (DBG_SEQ & 2)) { a.ph_lo = 151; a.ph_hi = 152; hipLaunchKernelGGL(hybrid_fwd, dim3(grid), dim3(NWAVES * 64), LDS_BYTES, stream, a); }
#endif
    }
#if DBG_LAST_PHASE < 28
    a.ph_lo = 200; a.ph_hi = 201;
    hipLaunchKernelGGL(hybrid_fwd, dim3(grid), dim3(NWAVES * 64), LDS_BYTES, stream, a);
#endif
#endif
}
```

```cpp
#include <hip/hip_runtime.h>
#include <cstdio>
#include <cstdint>
#define DBG_ZERO_OA 0
#define DBG_ZERO_OB 0
#define DBG_NO_STATE 0
#define DBG_NO_CARRY 0
#define DBG_ZLO 0
#define DBG_ZHI 0
#define DBG_CHECK 0
#define DBG_LAYER 0
#define DBG_THR 0.02f
#define DBG_LAST_PHASE 28
#define DBG_DUMP_OFF WS_XN
#define DBG_SUB 0
#define DBG_SEQ 0
#define DBG_WCHECK 0
#define DBG_NAIVE 0
#define DBG_NLAYERS 3
#define DBG_SPLIT8 0
#define DBG_NAIVEG 0
#define DBG_SIGLATE 0
namespace pg8 {
#define PG8_LAS __attribute__((address_space(3)))
typedef unsigned short bf16_t;
typedef short bf16x8 __attribute__((ext_vector_type(8)));
typedef float f32x4 __attribute__((ext_vector_type(4)));
typedef unsigned u32x4 __attribute__((ext_vector_type(4)));
constexpr int BM = 256, BK = 64, HALF = 128, HTB = HALF * BK * 2  , STAGE_BYTES = 8 * HTB, NXCD = 8, WGM = 8;

__host__ __device__ __forceinline__ int lds_byte(int r, int c) { const int st = (r >> 4) * 2 + (c >> 5), rr = r & 15, cc = c & 31, ob = rr * 64 + cc * 2; return st * 1024 + (ob ^ (((ob >> 9) & 1) << 5)); }
__host__ __device__ __forceinline__ void stage_rc(int b, int& R, int& C) { const int st = b / 1024, sb = b % 1024, swz = sb ^ (((sb >> 9) & 1) << 5); R = (st >> 1) * 16 + swz / 64; C = (st & 1) * 32 + (swz % 64) / 2; }
__host__ __device__ __forceinline__ int perm32(int rho) { const int n = rho >> 4, i = rho & 15; return 8 * (i >> 2) + 4 * n + (i & 3); }

struct Unit { int pm, pn; };
struct Gemm { const bf16_t* A; const bf16_t* Bt; int M, N, K; };

struct StaticOrder {
    int nM, nN, nwg, G, c;
    __host__ __device__ void init(int M, int N, int G_, int c_) { nM = M / BM; nN = N / BM; nwg = nM * nN; G = G_; c = c_; }
    __host__ __device__ bool next(int i, Unit& u) const {
        const long L = (long)i * G + c; if (L >= nwg) return false;
        int wgid = (int)L; { const int q = nwg / NXCD, r = nwg % NXCD, xcd = wgid % NXCD, off = wgid / NXCD; wgid = (xcd < r ? xcd * (q + 1) : r * (q + 1) + (xcd - r) * q) + off; }
        const int nig = WGM * nN, gid = wgid / nig, fm = gid * WGM, gsz = (nM - fm) < WGM ? (nM - fm) : WGM;
        u.pm = fm + ((wgid % nig) % gsz); u.pn = (wgid % nig) / gsz; return true;
    }
    __device__ __forceinline__ void a_ready(const Unit&) const {}
    __device__ __forceinline__ void done(const Unit&) const {}
};

__device__ __forceinline__ unsigned cvt_pk_bf16(float lo, float hi) { unsigned r; asm volatile("v_cvt_pk_bf16_f32 %0, %1, %2" : "=v"(r) : "v"(lo), "v"(hi)); return r; }
typedef float f32x2 __attribute__((ext_vector_type(2)));
__device__ __forceinline__ f32x2 gelu_pk(f32x2 v) {
    const f32x2 av = __builtin_elementwise_abs(v), d = av * 0.2316418882f + 1.0f;
    f32x2 t; t.x = __builtin_amdgcn_rcpf(d.x); t.y = __builtin_amdgcn_rcpf(d.y);
    f32x2 q = t * 0.5307027145f + (-0.7265760135f); q = q * t + 0.7107068705f; q = q * t + (-0.142248368f); q = q * t + 0.127414796f; q = q * t;
    const f32x2 s = (v * v) * (-0.72134752044f);
    f32x2 e; e.x = __builtin_amdgcn_exp2f(s.x); e.y = __builtin_amdgcn_exp2f(s.y);
    const f32x2 m = v * (q * e), r = v - m;
    f32x2 o; o.x = v.x < 0.f ? m.x : r.x; o.y = v.y < 0.f ? m.y : r.y; return o;
}

template <int ACT  > struct EpiBf16 {
    static constexpr bool PERM = true, AFTER_DRAIN = false; static_assert(ACT == 0 || ACT == 1, "EpiBf16: ACT is 0 (none) or 1 (gelu_pk)");
    bf16_t* O; int ldc; const float* bias; int split_cols; size_t split_stride; float scale0;
    __device__ __forceinline__ void operator()(const f32x4 (&acc)[2][2][4][2], const Unit& u, int wr, int wc, int fr, int fq) const {
        const int row0 = u.pm * BM + wr * 64 + fr; int colt = u.pn * BM; bf16_t* base = O;
        float sc = 1.f; if (split_cols) { const int t = colt / split_cols; base += (size_t)t * split_stride; colt -= t * split_cols; if (t == 0) sc = scale0; }
        const int col0 = colt + wc * 32 + 8 * fq, bcol0 = u.pn * BM + wc * 32 + 8 * fq;
        f32x4 bv[2][2];
#pragma unroll
        for (int bj = 0; bj < 2; ++bj)
#pragma unroll
            for (int n = 0; n < 2; ++n) bv[bj][n] = bias ? *(const f32x4*)(bias + bcol0 + bj * HALF + 4 * n) : (f32x4){0.f, 0.f, 0.f, 0.f};
#pragma unroll
        for (int ai = 0; ai < 2; ++ai)
#pragma unroll
            for (int m = 0; m < 4; ++m) { bf16_t* rowp = base + (size_t)(row0 + ai * HALF + m * 16) * ldc + col0;
#pragma unroll
                for (int bj = 0; bj < 2; ++bj) { f32x4 v0 = acc[ai][bj][m][0] + bv[bj][0], v1 = acc[ai][bj][m][1] + bv[bj][1];
                    if (ACT == 1) { f32x2 a = gelu_pk((f32x2){v0[0], v0[1]}), b = gelu_pk((f32x2){v0[2], v0[3]}), c = gelu_pk((f32x2){v1[0], v1[1]}), d = gelu_pk((f32x2){v1[2], v1[3]});
                        v0 = (f32x4){a.x, a.y, b.x, b.y}; v1 = (f32x4){c.x, c.y, d.x, d.y}; }
                    v0 = v0 * sc; v1 = v1 * sc; u32x4 w; w.x = cvt_pk_bf16(v0[0], v0[1]); w.y = cvt_pk_bf16(v0[2], v0[3]); w.z = cvt_pk_bf16(v1[0], v1[1]); w.w = cvt_pk_bf16(v1[2], v1[3]);
                    *(u32x4*)(rowp + bj * HALF) = w; } }
    }
};

struct PanelStats {
    unsigned* xbuf;
    unsigned* cnt;
    unsigned* tmo;
    int ntn; float eps;
    unsigned code;
    __device__ __forceinline__ bool run(const f32x4 (&v)[2][2][4][2], const Unit& u, int wr, int wc, int fr, int fq, PG8_LAS unsigned char* lds, int wid, int lane) const {
        typedef float f32x2v __attribute__((ext_vector_type(2)));
        PG8_LAS f32x2v* P = (PG8_LAS f32x2v*)lds;
        PG8_LAS f32x2v* S = (PG8_LAS f32x2v*)(lds + 8192);
        PG8_LAS unsigned* flag = (PG8_LAS unsigned*)(lds + 8192 + 2048);
#pragma unroll
        for (int ai = 0; ai < 2; ++ai)
#pragma unroll
            for (int m = 0; m < 4; ++m) {
                float s = 0.f;
#pragma unroll
                for (int bj = 0; bj < 2; ++bj)
#pragma unroll
                    for (int n = 0; n < 2; ++n) { const f32x4 x = v[ai][bj][m][n]; s += (x[0] + x[1]) + (x[2] + x[3]); }
                s += __shfl_xor(s, 16); s += __shfl_xor(s, 32);
                const float mw = s * (1.0f / 64.0f); float q = 0.f;
#pragma unroll
                for (int bj = 0; bj < 2; ++bj)
#pragma unroll
                    for (int n = 0; n < 2; ++n) { const f32x4 d = v[ai][bj][m][n] - mw; q += (d[0] * d[0] + d[1] * d[1]) + (d[2] * d[2] + d[3] * d[3]); }
                q += __shfl_xor(q, 16); q += __shfl_xor(q, 32);
                if (fq == 0) P[(ai * HALF + wr * 64 + m * 16 + fr) * 4 + wc] = (f32x2v){mw, q};
            }
        asm volatile("s_waitcnt lgkmcnt(0)" ::: "memory"); __builtin_amdgcn_s_barrier(); asm volatile("" ::: "memory");
#if defined(BROKEN_EXCHANGE_NO_WAIT)
#warning BROKEN CONTROL BUILD: the row-statistics exchange does not wait; results are wrong by design
        if (blockIdx.x >= 64) { const long long t0_ = clock64(); while (clock64() - t0_ < 60000) __builtin_amdgcn_s_sleep(8); }
#endif
        const int row = wid * 32 + (lane & 31);
        if (lane < 32) {
            const f32x2v a = P[row * 4 + 0], b = P[row * 4 + 1], c = P[row * 4 + 2], d = P[row * 4 + 3];
            const float mt = (a.x + b.x + c.x + d.x) * 0.25f;
            const float da = a.x - mt, db = b.x - mt, dc = c.x - mt, dd = d.x - mt;
            const float m2 = (a.y + b.y) + (c.y + d.y) + 64.0f * ((da * da + db * db) + (dc * dc + dd * dd));
            unsigned long long* slot = (unsigned long long*)xbuf + ((size_t)(u.pm * BM + row) * 4 + u.pn);
            __hip_atomic_store(slot, ((unsigned long long)__float_as_uint(m2) << 32) | __float_as_uint(mt), __ATOMIC_RELAXED, __HIP_MEMORY_SCOPE_AGENT);
        }
        asm volatile("s_waitcnt vmcnt(0)" ::: "memory");
        if (lane == 0) __hip_atomic_fetch_add(cnt + 64 * u.pm, 1u, __ATOMIC_RELAXED, __HIP_MEMORY_SCOPE_AGENT);
        if (wid == 0) {
            bool dead = false; const unsigned long long t0 = __builtin_amdgcn_s_memrealtime(); const unsigned want = 8u * (unsigned)ntn;
            for (;;) {
#if defined(BROKEN_EXCHANGE_NO_WAIT)
                break;
#endif
                if ((unsigned)__builtin_amdgcn_readfirstlane(__hip_atomic_load(cnt + 64 * u.pm, __ATOMIC_RELAXED, __HIP_MEMORY_SCOPE_AGENT)) >= want) break;
                if (__builtin_amdgcn_s_memrealtime() - t0 > 2000000ull) {
                    if (lane == 0) { unsigned expect = 0u; __hip_atomic_compare_exchange_strong(tmo + 1, &expect, code | (unsigned)(u.pm & 0xff), __ATOMIC_RELAXED, __ATOMIC_RELAXED, __HIP_MEMORY_SCOPE_AGENT);
                                     __hip_atomic_store(tmo, 1u, __ATOMIC_RELAXED, __HIP_MEMORY_SCOPE_AGENT); }
                    dead = true; break; }
                __builtin_amdgcn_s_sleep(2);
            }
            __builtin_amdgcn_fence(__ATOMIC_ACQUIRE, "agent");
            if (lane == 0) flag[0] = dead ? 1u : 0u;
        }
        asm volatile("s_waitcnt vmcnt(0) lgkmcnt(0)" ::: "memory"); __builtin_amdgcn_s_barrier(); asm volatile("" ::: "memory");
        const bool bad = flag[0] != 0u;
        if (lane < 32) {
            const unsigned long long* slot = (const unsigned long long*)xbuf + (size_t)(u.pm * BM + row) * 4; float mt[4], m2[4]; float ms = 0.f;
#pragma unroll
            for (int t = 0; t < 4; ++t) { if (t < ntn) { const unsigned long long w = __hip_atomic_load(slot + t, __ATOMIC_RELAXED, __HIP_MEMORY_SCOPE_AGENT); mt[t] = __uint_as_float((unsigned)w); m2[t] = __uint_as_float((unsigned)(w >> 32)); } else { mt[t] = 0.f; m2[t] = 0.f; } ms += mt[t]; }
            const float mean = ms / (float)ntn; float q = 0.f;
#pragma unroll
            for (int t = 0; t < 4; ++t) if (t < ntn) { const float dm = mt[t] - mean; q += m2[t] + 256.0f * dm * dm; }
            S[row] = (f32x2v){mean, 1.0f / sqrtf(q / (256.0f * (float)ntn) + eps)};
        }
        asm volatile("s_waitcnt lgkmcnt(0)" ::: "memory"); __builtin_amdgcn_s_barrier(); asm volatile("" ::: "memory");
        return bad;
    }
};
struct EpiLnRes {
    static constexpr bool PERM = false, AFTER_DRAIN = true;
    const float* base; float* out; int ldc; const float* bias; PanelStats st; unsigned poison;
    __device__ __forceinline__ void fused(f32x4 (&acc)[2][2][4][2], const Unit& u, int wr, int wc, int fr, int fq, PG8_LAS unsigned char* lds, int wid, int lane) const {
        typedef float f32x2v __attribute__((ext_vector_type(2)));
        const PG8_LAS f32x2v* S = (const PG8_LAS f32x2v*)(lds + 8192);
        const int col0 = u.pn * BM + wc * 32 + 4 * fq;
#pragma unroll
        for (int bj = 0; bj < 2; ++bj)
#pragma unroll
            for (int n = 0; n < 2; ++n) { const f32x4 bv = bias ? *(const f32x4*)(bias + col0 + bj * HALF + n * 16) : (f32x4){0.f, 0.f, 0.f, 0.f};
#pragma unroll
                for (int ai = 0; ai < 2; ++ai)
#pragma unroll
                    for (int m = 0; m < 4; ++m) acc[ai][bj][m][n] += bv; }
        f32x4 pre[4][2][2];
#pragma unroll
        for (int m = 0; m < 4; ++m) { const size_t off = (size_t)(u.pm * BM + wr * 64 + m * 16 + fr) * ldc + col0;
#pragma unroll
            for (int bj = 0; bj < 2; ++bj)
#pragma unroll
                for (int n = 0; n < 2; ++n) pre[m][bj][n] = *(const f32x4*)(base + off + bj * HALF + n * 16); }
        const bool bad = st.run(acc, u, wr, wc, fr, fq, lds, wid, lane) || poison != 0u;
        const float qnan = __builtin_nanf("");
#pragma unroll
        for (int ai = 0; ai < 2; ++ai)
#pragma unroll
            for (int m = 0; m < 4; ++m) { const int r = ai * HALF + wr * 64 + m * 16 + fr; const f32x2v sr = S[r]; const size_t off = (size_t)(u.pm * BM + r) * ldc + col0;
#pragma unroll
                for (int bj = 0; bj < 2; ++bj)
#pragma unroll
                    for (int n = 0; n < 2; ++n) { const f32x4 bs = ai == 0 ? pre[m][bj][n] : *(const f32x4*)(base + off + bj * HALF + n * 16); f32x4 o = bs + (acc[ai][bj][m][n] - sr.x) * sr.y;
                        if (bad) o = (f32x4){qnan, qnan, qnan, qnan}; *(f32x4*)(out + off + bj * HALF + n * 16) = o; }
                if (m & 1) asm volatile("" ::: "memory"); }
    }
};
struct EpiLnResLn {
    static constexpr bool PERM = false, AFTER_DRAIN = true;
    const float* base; float* out; bf16_t* xn; int ldc; const float* bias; PanelStats st1, st2; unsigned poison;
    __device__ __forceinline__ void fused(f32x4 (&acc)[2][2][4][2], const Unit& u, int wr, int wc, int fr, int fq, PG8_LAS unsigned char* lds, int wid, int lane) const {
        typedef float f32x2v __attribute__((ext_vector_type(2))); typedef unsigned u32x2v __attribute__((ext_vector_type(2)));
        const PG8_LAS f32x2v* S = (const PG8_LAS f32x2v*)(lds + 8192);
        const int col0 = u.pn * BM + wc * 32 + 4 * fq;
#pragma unroll
        for (int bj = 0; bj < 2; ++bj)
#pragma unroll
            for (int n = 0; n < 2; ++n) { const f32x4 bv = bias ? *(const f32x4*)(bias + col0 + bj * HALF + n * 16) : (f32x4){0.f, 0.f, 0.f, 0.f};
#pragma unroll
                for (int ai = 0; ai < 2; ++ai)
#pragma unroll
                    for (int m = 0; m < 4; ++m) acc[ai][bj][m][n] += bv; }
        bool bad = st1.run(acc, u, wr, wc, fr, fq, lds, wid, lane) || poison != 0u;
        const float qnan = __builtin_nanf("");
#pragma unroll
        for (int ai = 0; ai < 2; ++ai)
#pragma unroll
            for (int m = 0; m < 4; ++m) { const int r = ai * HALF + wr * 64 + m * 16 + fr; const f32x2v sr = S[r]; const size_t off = (size_t)(u.pm * BM + r) * ldc + col0;
#pragma unroll
                for (int bj = 0; bj < 2; ++bj)
#pragma unroll
                    for (int n = 0; n < 2; ++n) { const f32x4 bs = *(const f32x4*)(base + off + bj * HALF + n * 16); acc[ai][bj][m][n] = bs + (acc[ai][bj][m][n] - sr.x) * sr.y; }
                asm volatile("" : "+v"(acc[ai][0][m][0]), "+v"(acc[ai][0][m][1]), "+v"(acc[ai][1][m][0]), "+v"(acc[ai][1][m][1]));
                if (m & 1) asm volatile("" ::: "memory"); }
        const bool bad1 = bad;
        bad = st2.run(acc, u, wr, wc, fr, fq, lds, wid, lane) || bad;
#pragma unroll
        for (int ai = 0; ai < 2; ++ai)
#pragma unroll
            for (int m = 0; m < 4; ++m) { const int r = ai * HALF + wr * 64 + m * 16 + fr; const f32x2v sr = S[r]; const size_t off = (size_t)(u.pm * BM + r) * ldc + col0;
#pragma unroll
                for (int bj = 0; bj < 2; ++bj)
#pragma unroll
                    for (int n = 0; n < 2; ++n) { const f32x4 x1 = acc[ai][bj][m][n]; *(f32x4*)(out + off + bj * HALF + n * 16) = bad1 ? (f32x4){qnan, qnan, qnan, qnan} : x1;
                        const f32x4 o = (x1 - sr.x) * sr.y; u32x2v w; w.x = cvt_pk_bf16(o[0], o[1]); w.y = cvt_pk_bf16(o[2], o[3]);
                        if (bad) { w.x = 0x7fc07fc0u; w.y = 0x7fc07fc0u; } *(u32x2v*)(xn + off + bj * HALF + n * 16) = w; }
                asm volatile("" ::: "memory"); }
    }
};

template <class Epi, class Sched, bool ALIGN_EPI = false, bool SP2 = false>
__device__ __forceinline__ void gemm_phase(PG8_LAS unsigned char* lds, const Gemm g, const Sched& S, const Epi& E) {
    int tid_l = threadIdx.x; asm volatile("" : "+v"(tid_l));
    const int tid = tid_l, wid = __builtin_amdgcn_readfirstlane(tid >> 6), lane = tid & 63, wr = wid >> 2, wc = wid & 3, fr = lane & 15, fq = lane >> 4;
    const int K = g.K, nt = K / BK;
    unsigned voffA[2], voffB[2];
#pragma unroll
    for (int i = 0; i < 2; ++i) { int R, C; stage_rc(tid * 16 + i * 8192, R, C); const int Rb = Epi::PERM ? ((R & ~31) + perm32(R & 31)) : R;
        voffA[i] = (unsigned)(R * K + C) * 2u; voffB[i] = (unsigned)(Rb * K + C) * 2u; }
    const size_t kstep = (size_t)(BK * 2);
    const size_t hstep = (size_t)HALF * K * 2;
    const size_t tstep = 2 * hstep;
    const unsigned ldsw = (unsigned)wid * 1024u;
    const int aoff = lds_byte(wr * 64 + fr, fq * 8), boff = lds_byte(wc * 32 + fr, fq * 8);
#define PG8_SA(b, h) (((b) * 2 + (h)) * HTB)
#define PG8_SB(b, h) ((4 + (b) * 2 + (h)) * HTB)
#define PG8_STAGE(bufoff, gbase, voff) do { _Pragma("unroll") for (int _i = 0; _i < 2; ++_i) \
        __builtin_amdgcn_global_load_lds((const unsigned*)((const char*)(gbase) + (voff)[_i]), (PG8_LAS unsigned*)(lds + (bufoff) + ldsw + _i * 8192), 16, 0, 0); } while (0)
#define PG8_LDA(dst, b, h) do { _Pragma("unroll") for (int m = 0; m < 4; ++m) _Pragma("unroll") for (int k = 0; k < 2; ++k) dst[m][k] = *(const PG8_LAS bf16x8*)(lds + PG8_SA(b, h) + aoff + m * 2048 + k * 1024); } while (0)
#define PG8_LDB(dst, b, h) do { _Pragma("unroll") for (int n = 0; n < 2; ++n) _Pragma("unroll") for (int k = 0; k < 2; ++k) dst[n][k] = *(const PG8_LAS bf16x8*)(lds + PG8_SB(b, h) + boff + n * 2048 + k * 1024); } while (0)
#define PG8_MMA(ai, bj, At, Bt) do { __builtin_amdgcn_s_setprio(1); _Pragma("unroll") for (int m = 0; m < 4; ++m) _Pragma("unroll") for (int n = 0; n < 2; ++n) _Pragma("unroll") for (int k = 0; k < 2; ++k) \
        acc[ai][bj][m][n] = __builtin_amdgcn_mfma_f32_16x16x32_bf16(Bt[n][k], At[m][k], acc[ai][bj][m][n], 0, 0, 0); __builtin_amdgcn_s_setprio(0); } while (0)
#define PG8_WAIT_V(n) asm volatile("s_waitcnt vmcnt(" #n ")" ::: "memory")
#define PG8_WAIT_L(n) asm volatile("s_waitcnt lgkmcnt(" #n ")" ::: "memory")
#define PG8_BAR __builtin_amdgcn_s_barrier()
#define PG8_SCHED __builtin_amdgcn_sched_barrier(0)
    Unit cur, nxt; int ui = 0;
    if (!S.next(0, cur)) return;
    f32x4 acc[2][2][4][2];
#pragma unroll
    for (int a = 0; a < 2; ++a)
#pragma unroll
        for (int b = 0; b < 2; ++b)
#pragma unroll
            for (int m = 0; m < 4; ++m)
#pragma unroll
                for (int n = 0; n < 2; ++n) acc[a][b][m][n] = (f32x4){0.f, 0.f, 0.f, 0.f};
    bf16x8 At[4][2], B0[2][2], B1[2][2];
    const char* cA = (const char*)g.A + (size_t)cur.pm * tstep; const char* cB = (const char*)g.Bt + (size_t)cur.pn * tstep;
    S.a_ready(cur);
    if constexpr (SP2) {
        PG8_STAGE(PG8_SB(0, 0), cB, voffB); PG8_STAGE(PG8_SB(0, 1), cB + hstep, voffB); PG8_STAGE(PG8_SA(0, 0), cA, voffA); PG8_STAGE(PG8_SA(0, 1), cA + hstep, voffA);
        if (wr == 1) PG8_BAR;
        PG8_WAIT_V(2); PG8_BAR;
        PG8_STAGE(PG8_SB(1, 0), cB + kstep, voffB); PG8_STAGE(PG8_SA(1, 0), cA + kstep, voffA); PG8_STAGE(PG8_SB(1, 1), cB + hstep + kstep, voffB);
        PG8_WAIT_V(6); PG8_BAR;
    } else {
        PG8_STAGE(PG8_SB(0, 0), cB, voffB); PG8_STAGE(PG8_SA(0, 0), cA, voffA); PG8_STAGE(PG8_SB(0, 1), cB + hstep, voffB); PG8_STAGE(PG8_SA(0, 1), cA + hstep, voffA);
        if (wr == 1) PG8_BAR;
        PG8_WAIT_V(4); PG8_BAR;
        PG8_STAGE(PG8_SB(1, 0), cB + kstep, voffB); PG8_STAGE(PG8_SA(1, 0), cA + kstep, voffA); PG8_STAGE(PG8_SB(1, 1), cB + hstep + kstep, voffB);
        PG8_WAIT_V(6); PG8_BAR;
    }
    for (;;) {
        const bool has_next = S.next(ui + 1, nxt);
        const char* nA = has_next ? (const char*)g.A + (size_t)nxt.pm * tstep : cA; const char* nB = has_next ? (const char*)g.Bt + (size_t)nxt.pn * tstep : cB;
        for (int t = 0; t < nt; t += 2) {
            const bool last = (t == nt - 2);
            const char* a1 = cA + (size_t)(t + 1) * kstep;
            const char* a2 = last ? nA : cA + (size_t)(t + 2) * kstep; const char* b2 = last ? nB : cB + (size_t)(t + 2) * kstep;
            const char* a3 = a2 + kstep; const char* b3 = b2 + kstep;
            if (last && has_next) S.a_ready(nxt);
            if constexpr (SP2) {
            PG8_LDB(B0, 0, 0); PG8_LDB(B1, 0, 1); PG8_SCHED; PG8_LDA(At, 0, 0); PG8_STAGE(PG8_SA(1, 1), a1 + hstep, voffA);
            PG8_WAIT_V(8); PG8_WAIT_L(0); PG8_BAR; PG8_MMA(0, 0, At, B0); PG8_MMA(0, 1, At, B1); PG8_BAR; PG8_SCHED;
            PG8_LDA(At, 0, 1); PG8_STAGE(PG8_SB(0, 0), b2, voffB); PG8_STAGE(PG8_SB(0, 1), b2 + hstep, voffB); PG8_STAGE(PG8_SA(0, 0), a2, voffA);
            PG8_WAIT_V(8); PG8_WAIT_L(0); PG8_BAR; PG8_MMA(1, 0, At, B0); PG8_MMA(1, 1, At, B1); PG8_BAR; PG8_SCHED;
            PG8_LDB(B0, 1, 0); PG8_LDB(B1, 1, 1); PG8_SCHED; PG8_LDA(At, 1, 0); PG8_STAGE(PG8_SA(0, 1), a2 + hstep, voffA);
            PG8_WAIT_V(8); PG8_WAIT_L(0); PG8_BAR; PG8_MMA(0, 0, At, B0); PG8_MMA(0, 1, At, B1); PG8_BAR; PG8_SCHED;
            PG8_LDA(At, 1, 1); PG8_STAGE(PG8_SB(1, 0), b3, voffB); PG8_STAGE(PG8_SB(1, 1), b3 + hstep, voffB); PG8_STAGE(PG8_SA(1, 0), a3, voffA);
            PG8_WAIT_V(8); PG8_WAIT_L(0); PG8_BAR; PG8_MMA(1, 0, At, B0); PG8_MMA(1, 1, At, B1); PG8_BAR; PG8_SCHED;
            } else {
            PG8_LDB(B0, 0, 0); PG8_SCHED; PG8_LDA(At, 0, 0); PG8_STAGE(PG8_SA(1, 1), a1 + hstep, voffA);
            PG8_WAIT_L(8); PG8_BAR; PG8_WAIT_L(0); PG8_MMA(0, 0, At, B0); PG8_BAR; PG8_SCHED;
            PG8_LDB(B1, 0, 1); PG8_STAGE(PG8_SB(0, 0), b2, voffB);
            PG8_BAR; PG8_WAIT_L(0); PG8_MMA(0, 1, At, B1); PG8_BAR;
            PG8_LDA(At, 0, 1); PG8_STAGE(PG8_SA(0, 0), a2, voffA);
            PG8_BAR; PG8_WAIT_L(0); PG8_MMA(1, 0, At, B0); PG8_BAR; PG8_SCHED;
            PG8_STAGE(PG8_SB(0, 1), b2 + hstep, voffB);
            PG8_WAIT_V(6); PG8_BAR; PG8_MMA(1, 1, At, B1); PG8_BAR;
            PG8_LDB(B0, 1, 0); PG8_SCHED; PG8_LDA(At, 1, 0); PG8_STAGE(PG8_SA(0, 1), a2 + hstep, voffA);
            PG8_WAIT_L(8); PG8_BAR; PG8_WAIT_L(0); PG8_MMA(0, 0, At, B0); PG8_BAR; PG8_SCHED;
            PG8_LDB(B1, 1, 1); PG8_STAGE(PG8_SB(1, 0), b3, voffB);
            PG8_BAR; PG8_WAIT_L(0); PG8_MMA(0, 1, At, B1); PG8_BAR;
            PG8_LDA(At, 1, 1); PG8_STAGE(PG8_SA(1, 0), a3, voffA);
            PG8_BAR; PG8_WAIT_L(0); PG8_MMA(1, 0, At, B0); PG8_BAR; PG8_SCHED;
            PG8_STAGE(PG8_SB(1, 1), b3 + hstep, voffB);
            PG8_WAIT_V(6); PG8_BAR; PG8_MMA(1, 1, At, B1); PG8_BAR;
            }
        }
        if constexpr (ALIGN_EPI) { if (wr == 0) PG8_BAR; }
        if constexpr (!Epi::AFTER_DRAIN) { E(acc, cur, wr, wc, fr, fq); S.done(cur); }
        if (!has_next) break;
#pragma unroll
        for (int a = 0; a < 2; ++a)
#pragma unroll
            for (int b = 0; b < 2; ++b)
#pragma unroll
                for (int m = 0; m < 4; ++m)
#pragma unroll
                    for (int n = 0; n < 2; ++n) acc[a][b][m][n] = (f32x4){0.f, 0.f, 0.f, 0.f};
        cur = nxt; cA = nA; cB = nB; ++ui;
        if constexpr (ALIGN_EPI) { if (wr == 1) PG8_BAR; }
    }
    PG8_WAIT_V(0);
    if constexpr (!ALIGN_EPI) { if (wr == 0) PG8_BAR; }
    PG8_BAR;
    if constexpr (Epi::AFTER_DRAIN) { E.fused(acc, cur, wr, wc, fr, fq, lds, wid, lane); S.done(cur); }
#undef PG8_SA
#undef PG8_SB
#undef PG8_STAGE
#undef PG8_LDA
#undef PG8_LDB
#undef PG8_MMA
#undef PG8_WAIT_V
#undef PG8_WAIT_L
#undef PG8_BAR
#undef PG8_SCHED
}
}
namespace pg8 {
__device__ __forceinline__ float sigmoidf_fast(float x) { return __builtin_amdgcn_rcpf(1.0f + __expf(-x)); }
typedef float f32x2_c __attribute__((ext_vector_type(2))); typedef __bf16 bf16x2_c __attribute__((ext_vector_type(2)));
__device__ __forceinline__ unsigned cvt_pk_safe(float lo, float hi) { const f32x2_c v = {lo, hi}; const bf16x2_c b = __builtin_convertvector(v, bf16x2_c); return __builtin_bit_cast(unsigned, b); }
struct EpiSwiglu {
    static constexpr bool PERM = true, AFTER_DRAIN = false;
    bf16_t* O; int ldc;
    __device__ __forceinline__ void operator()(const f32x4 (&acc)[2][2][4][2], const Unit& u, int wr, int wc, int fr, int fq) const {
        const int row0 = u.pm * BM + wr * 64 + fr, col0 = u.pn * HALF + wc * 32 + 8 * fq;
#pragma unroll
        for (int ai = 0; ai < 2; ++ai)
#pragma unroll
            for (int m = 0; m < 4; ++m) { bf16_t* rowp = O + (size_t)(row0 + ai * HALF + m * 16) * ldc + col0;
                float v[8];
#pragma unroll
                for (int n = 0; n < 2; ++n)
#pragma unroll
                    for (int e = 0; e < 4; ++e) { const float g = acc[ai][0][m][n][e], up = acc[ai][1][m][n][e]; v[n * 4 + e] = g * sigmoidf_fast(g) * up; }
                u32x4 w; w.x = cvt_pk_safe(v[0], v[1]); w.y = cvt_pk_safe(v[2], v[3]); w.z = cvt_pk_safe(v[4], v[5]); w.w = cvt_pk_safe(v[6], v[7]);
                *(u32x4*)rowp = w; }
    }
};
template <int ACT> struct EpiMap {
    static constexpr bool PERM = true, AFTER_DRAIN = false;
    bf16_t* O0; int ld0; int t1; bf16_t* O1; int ld1;
    __device__ __forceinline__ void operator()(const f32x4 (&acc)[2][2][4][2], const Unit& u, int wr, int wc, int fr, int fq) const {
        const int row0 = u.pm * BM + wr * 64 + fr;
        bf16_t* base; int ld, colt;
        if (u.pn < t1) { base = O0; ld = ld0; colt = u.pn * BM; } else { base = O1; ld = ld1; colt = (u.pn - t1) * BM; }
        const int col0 = colt + wc * 32 + 8 * fq;
#pragma unroll
        for (int ai = 0; ai < 2; ++ai)
#pragma unroll
            for (int m = 0; m < 4; ++m) { bf16_t* rowp = base + (size_t)(row0 + ai * HALF + m * 16) * ld + col0;
#pragma unroll
                for (int bj = 0; bj < 2; ++bj) { f32x4 v0 = acc[ai][bj][m][0], v1 = acc[ai][bj][m][1];
                    if (ACT == 1) {
#pragma unroll
                        for (int e = 0; e < 4; ++e) { v0[e] = sigmoidf_fast(v0[e]); v1[e] = sigmoidf_fast(v1[e]); } }
                    u32x4 w; w.x = cvt_pk_safe(v0[0], v0[1]); w.y = cvt_pk_safe(v0[2], v0[3]); w.z = cvt_pk_safe(v1[0], v1[1]); w.w = cvt_pk_safe(v1[2], v1[3]);
                    *(u32x4*)(rowp + bj * HALF) = w; } }
    }
};
__device__ __forceinline__ float bfu_lo(unsigned w) { return __uint_as_float(w << 16); }
__device__ __forceinline__ float bfu_hi(unsigned w) { return __uint_as_float(w & 0xffff0000u); }
template <int MODE> struct EpiGateMerge {
    static constexpr bool PERM = true, AFTER_DRAIN = false;
    bf16_t* Y; int ldy; const bf16_t* G; int ldg; int goff;
    __device__ __forceinline__ void operator()(const f32x4 (&acc)[2][2][4][2], const Unit& u, int wr, int wc, int fr, int fq) const {
        const int row0 = u.pm * BM + wr * 64 + fr, col0 = u.pn * BM + wc * 32 + 8 * fq;
#pragma unroll
        for (int ai = 0; ai < 2; ++ai)
#pragma unroll
            for (int m = 0; m < 4; ++m) { const size_t r = (size_t)(row0 + ai * HALF + m * 16);
#pragma unroll
                for (int bj = 0; bj < 2; ++bj) { const int c = col0 + bj * HALF;
                    const u32x4 gv = *(const u32x4*)(G + r * ldg + goff + c);
                    const f32x4 a0 = acc[ai][bj][m][0], a1 = acc[ai][bj][m][1];
                    float v[8];
                    float gq[8] = {bfu_lo(gv.x), bfu_hi(gv.x), bfu_lo(gv.y), bfu_hi(gv.y), bfu_lo(gv.z), bfu_hi(gv.z), bfu_lo(gv.w), bfu_hi(gv.w)};
#if DBG_SIGLATE
#pragma unroll
                    for (int e = 0; e < 8; ++e) gq[e] = sigmoidf_fast(gq[e]);
#endif
                    v[0] = gq[0] * a0[0]; v[1] = gq[1] * a0[1]; v[2] = gq[2] * a0[2]; v[3] = gq[3] * a0[3];
                    v[4] = gq[4] * a1[0]; v[5] = gq[5] * a1[1]; v[6] = gq[6] * a1[2]; v[7] = gq[7] * a1[3];
                    if (MODE == 1) { const u32x4 yv = *(const u32x4*)(Y + r * ldy + c);
                        v[0] += bfu_lo(yv.x); v[1] += bfu_hi(yv.x); v[2] += bfu_lo(yv.y); v[3] += bfu_hi(yv.y);
                        v[4] += bfu_lo(yv.z); v[5] += bfu_hi(yv.z); v[6] += bfu_lo(yv.w); v[7] += bfu_hi(yv.w); }
                    u32x4 w; w.x = cvt_pk_safe(v[0], v[1]); w.y = cvt_pk_safe(v[2], v[3]); w.z = cvt_pk_safe(v[4], v[5]); w.w = cvt_pk_safe(v[6], v[7]);
                    *(u32x4*)(Y + r * ldy + c) = w; } }
    }
};
struct PairOrder { Unit base;
    __device__ __forceinline__ bool next(int i, Unit& u) const { if (i >= 2) return false; u.pm = base.pm; u.pn = base.pn + 4 * i; return true; }
    __device__ __forceinline__ void a_ready(const Unit&) const {}
    __device__ __forceinline__ void done(const Unit&) const {} };
struct OneUnit { Unit base;
    __device__ __forceinline__ bool next(int i, Unit& u) const { if (i >= 1) return false; u = base; return true; }
    __device__ __forceinline__ void a_ready(const Unit&) const {}
    __device__ __forceinline__ void done(const Unit&) const {} };
}
constexpr int NWAVES = 8, GRID = 256;
constexpr int BATCH = 2, T = 8192, M = BATCH * T, D = 1024, FF = 2816, NUP = 2 * FF, WIN = 4864, WSH = 1792, RW = 512, LW = 512, NH = 8, HD = 64;
constexpr int NAL = 2816;
constexpr int NGT = 2048;
constexpr int NCHUNK = M / 64;
constexpr int NCH_SEQ = T / 64;
constexpr float RMS_EPS = 1e-6f, GN_EPS = 64e-5f;
constexpr int PH_PER_LAYER = 14, N_PHASES = 2 * PH_PER_LAYER;

constexpr size_t MiB = 1u << 20;
constexpr size_t WS_CTL = 0, CTL_ZERO_BYTES = 64 * 1024;
constexpr size_t WS_WUP = 1 * MiB;
constexpr size_t WS_WDN = WS_WUP + (size_t)NUP * D * 2;
constexpr size_t WS_WIN = 18 * MiB;
constexpr size_t WS_PAT = WS_WIN + (size_t)WIN * D * 2;
constexpr size_t WS_PBT = WS_PAT + (size_t)D * RW * 2;
constexpr size_t WS_WOT = WS_PBT + (size_t)D * LW * 2;
constexpr size_t WS_SMALL = WS_WOT + (size_t)D * D * 2;
constexpr size_t WS_WUT = WS_SMALL;
constexpr size_t WS_AUT = WS_WUT + 512 * 64 * 2;
constexpr size_t WS_GUT = WS_AUT + 512 * 64 * 2;
constexpr size_t WS_VDT = WS_GUT + 512 * 128 * 2;
constexpr size_t WS_VUT = WS_VDT + 32 * 512 * 2;
constexpr size_t WS_LWA = WS_VUT + 512 * 32 * 2;
constexpr size_t WS_LWX = WS_LWA + 8 * 64 * 64 * 2;
constexpr size_t WS_SMALL_END = WS_LWX + 8 * 64 * 64 * 2;
static_assert(WS_WDN + (size_t)D * FF * 2 <= WS_WIN && WS_SMALL_END <= 32 * MiB, "weight map");
constexpr size_t WS_VF = 32 * MiB;
constexpr size_t WS_XN = 48 * MiB;
constexpr size_t WS_BS = 80 * MiB;
constexpr size_t WS_AGG = 81 * MiB;
constexpr size_t WS_GG = 82 * MiB;
constexpr size_t WS_LOC = 98 * MiB;
constexpr size_t WS_H = WS_LOC;
constexpr size_t WS_PA = WS_LOC;
constexpr size_t WS_PL = WS_LOC + 56 * MiB;
constexpr size_t WS_SP = WS_LOC + 88 * MiB;
constexpr size_t WS_SQ = WS_SP + 16 * MiB;
constexpr size_t WS_SR = WS_SQ + 16 * MiB;
constexpr size_t WS_SY = WS_SR + 16 * MiB;
constexpr size_t WS_HC = WS_LOC;
constexpr size_t WS_HL = WS_LOC + 16 * MiB;
constexpr size_t WS_AP = WS_LOC + 32 * MiB;
constexpr size_t WS_OA = WS_SP;
constexpr size_t WS_OB = WS_SQ;
constexpr size_t WS_G = WS_LOC;
constexpr size_t WS_Y = WS_SR;
constexpr size_t WS_END = WS_SY + 16 * MiB;
static_assert(WS_END <= 256 * MiB && WS_H + (size_t)M * FF * 2 <= 256 * MiB && WS_G + (size_t)M * NGT * 2 <= WS_SP, "d_ws map");
constexpr int CW_BAR = 1024;

constexpr int SLOT = 8192;
constexpr int LDS_WORK = 18 * SLOT;
constexpr int MISC_OFF = LDS_WORK;
constexpr int TAB_OFF = MISC_OFF + 256;
constexpr int LDS_BYTES = LDS_WORK + 1024;

#define GAS __attribute__((address_space(1)))
#define LAS __attribute__((address_space(3)))
typedef unsigned short bf16;
typedef unsigned v4u __attribute__((ext_vector_type(4)));
typedef unsigned v2u __attribute__((ext_vector_type(2)));
typedef float f32x4 __attribute__((ext_vector_type(4)));
typedef short bf16x8 __attribute__((ext_vector_type(8)));
typedef GAS unsigned gu32;
typedef LAS unsigned char* lptr;
#define RLX_AGENT __ATOMIC_RELAXED, __HIP_MEMORY_SCOPE_AGENT
#define LDS_WAIT() asm volatile("s_waitcnt lgkmcnt(0)" ::: "memory")
#define VM_WAIT() asm volatile("s_waitcnt vmcnt(0)" ::: "memory")
__device__ __forceinline__ unsigned f2bf(float f) { unsigned u = __builtin_bit_cast(unsigned, f); return (u + 0x7fffu + ((u >> 16) & 1u)) >> 16; }
__device__ __forceinline__ unsigned pk2(float lo, float hi) { return f2bf(lo) | (f2bf(hi) << 16); }
__device__ __forceinline__ float bf2f(unsigned h) { return __uint_as_float(h << 16); }
__device__ __forceinline__ float bflo(unsigned w) { return __uint_as_float(w << 16); }
__device__ __forceinline__ float bfhi(unsigned w) { return __uint_as_float(w & 0xffff0000u); }
__device__ __forceinline__ float sigm(float x) { return __builtin_amdgcn_rcpf(1.0f + __expf(-x)); }
__device__ __forceinline__ float tanh_fast(float x) { const float e = __expf(2.0f * x); return 1.0f - 2.0f * __builtin_amdgcn_rcpf(e + 1.0f); }
__device__ __forceinline__ float bperm(float v, int src_lane) { return __int_as_float(__builtin_amdgcn_ds_bpermute(src_lane << 2, __float_as_int(v))); }
__device__ __forceinline__ float wave_sum(float v, int lane) {
#pragma unroll
    for (int o = 1; o < 64; o <<= 1) v += bperm(v, lane ^ o);
    return v;
}
__device__ __forceinline__ f32x4 mfma16(bf16x8 a, bf16x8 b, f32x4 c) { return __builtin_amdgcn_mfma_f32_16x16x32_bf16(a, b, c, 0, 0, 0); }

__device__ __forceinline__ int sw_off(int r, int c) { return r * 128 + ((c << 1) ^ ((r & 7) << 4)); }
__device__ __forceinline__ bf16x8 lds_frag(lptr base, int row, int c8) { return *(const LAS bf16x8*)(base + sw_off(row, c8)); }
__device__ __forceinline__ void lds_st16(lptr base, int r, int c, float v) { *(LAS bf16*)(base + sw_off(r, c)) = (bf16)f2bf(v); }
__device__ __forceinline__ float lds_ld16(lptr base, int r, int c) { return bf2f(*(const LAS bf16*)(base + sw_off(r, c))); }
__device__ __forceinline__ void lds_st4(lptr base, int r, int c4, f32x4 v) { v2u w; w.x = pk2(v[0], v[1]); w.y = pk2(v[2], v[3]); *(LAS v2u*)(base + sw_off(r, c4)) = w; }
__device__ __forceinline__ f32x4 lds_ld4(lptr base, int r, int c4) { const v2u w = *(const LAS v2u*)(base + sw_off(r, c4)); return (f32x4){bflo(w.x), bfhi(w.x), bflo(w.y), bfhi(w.y)}; }
__device__ __forceinline__ bf16x8 gl_frag(const bf16* p) { return *(const GAS bf16x8*)p; }
__device__ __forceinline__ f32x4 gl_ld4(const bf16* p) { const v2u w = *(const GAS v2u*)p; return (f32x4){bflo(w.x), bfhi(w.x), bflo(w.y), bfhi(w.y)}; }
__device__ __forceinline__ void gl_st4(bf16* p, f32x4 v) { v2u w; w.x = pk2(v[0], v[1]); w.y = pk2(v[2], v[3]); *(GAS v2u*)p = w; }

template <bool SW>
__device__ __forceinline__ void mma64(f32x4 (&acc)[2], lptr A, lptr B, int mt, int ntb, int lane) {
    const int r16 = lane & 15, g = lane >> 4;
#pragma unroll
    for (int s = 0; s < 2; ++s) {
        const bf16x8 a = lds_frag(A, 16 * mt + r16, 32 * s + 8 * g);
#pragma unroll
        for (int q = 0; q < 2; ++q) {
            const bf16x8 b = lds_frag(B, 16 * (ntb + q) + r16, 32 * s + 8 * g);
            acc[q] = SW ? mfma16(b, a, acc[q]) : mfma16(a, b, acc[q]);
        }
    }
}
#define ZERO2(acc) do { acc[0] = (f32x4){0.f, 0.f, 0.f, 0.f}; acc[1] = (f32x4){0.f, 0.f, 0.f, 0.f}; } while (0)
#define WG_BAR() do { asm volatile("s_waitcnt vmcnt(0) lgkmcnt(0)" ::: "memory"); __builtin_amdgcn_s_barrier(); asm volatile("" ::: "memory"); } while (0)
#define XB_TMO      128
#define XB_XCNT(j)  (256  + 64 * (j))
#define XB_XSUB(j)  (1280 + 64 * (j))
#define XB_XGEN(j)  (2304 + 64 * (j))
#define XB_TOP      3328
#define XB_TOPGEN   3392
#define XCD_BAR_WORDS 3456
#define XB_SPIN_CAP (1u << 18)

__device__ __forceinline__ unsigned xb_ld(unsigned* p)              { return __hip_atomic_load(p, __ATOMIC_RELAXED, __HIP_MEMORY_SCOPE_AGENT); }
__device__ __forceinline__ unsigned xb_add(unsigned* p, unsigned v) { return __hip_atomic_fetch_add(p, v, __ATOMIC_RELAXED, __HIP_MEMORY_SCOPE_AGENT); }
__device__ __forceinline__ unsigned xb_xcc_id() { return (unsigned)__builtin_amdgcn_s_getreg((3 << 11) | 20) & 0xFu; }
#define XB_SPIN(cond, bar) do { unsigned _sp = 0; while (cond) { __builtin_amdgcn_s_sleep(1); \
    if ((++_sp & 255u) == 0u) { if (xb_ld(&(bar)[XB_TMO])) break; if (_sp > XB_SPIN_CAP) { atomicAdd(&(bar)[XB_TMO], 1u); break; } } } } while (0)

struct XcdBarrier {
    unsigned* bar; unsigned x;
    volatile LAS unsigned* st;
};

__device__ __forceinline__ XcdBarrier xcd_barrier_post(unsigned* bar, volatile LAS unsigned* st) {
    XcdBarrier b; b.bar = bar; b.x = xb_xcc_id(); b.st = st;
    if (threadIdx.x == 0) (void)xb_add(&bar[XB_XCNT(b.x)], 1u);
    return b;
}
__device__ __forceinline__ void xcd_barrier_complete(unsigned* bar, unsigned x, unsigned& nloc, unsigned& nx) {
    const unsigned G = gridDim.x * gridDim.y * gridDim.z;
    unsigned sum, cnt, mine, sp = 0u;
    for (;;) {
        sum = 0u; cnt = 0u; mine = 0u;
#pragma unroll
        for (unsigned j = 0; j < 16; ++j) { const unsigned c = xb_ld(&bar[XB_XCNT(j)]); sum += c; cnt += (c > 0u) ? 1u : 0u; mine = (j == x) ? c : mine; }
        if (sum == G) break;
        __builtin_amdgcn_s_sleep(1);
        if ((++sp & 255u) == 0u) { if (xb_ld(&bar[XB_TMO])) break; if (sp > XB_SPIN_CAP) { atomicAdd(&bar[XB_TMO], 1u); break; } }
    }
    nloc = mine > 0u ? mine : 1u; nx = cnt > 0u ? cnt : 1u;
}

__device__ __forceinline__ void xcd_barrier(const XcdBarrier& b) {
    asm volatile("s_waitcnt vmcnt(0)" ::: "memory");
    __syncthreads();
    if (threadIdx.x == 0) {
        unsigned* bar = b.bar;
        __builtin_amdgcn_s_waitcnt(0);
        unsigned nloc = b.st[0], nx = b.st[1];
        if (nloc == 0u) { xcd_barrier_complete(bar, b.x, nloc, nx); b.st[0] = nloc; b.st[1] = nx; }
        const unsigned old = xb_add(&bar[XB_XSUB(b.x)], 1u);
        const unsigned gen = old / nloc;
        if (old + 1u == (gen + 1u) * nloc) {
            __builtin_amdgcn_fence(__ATOMIC_RELEASE, "agent");
            asm volatile("s_waitcnt vmcnt(0)" ::: "memory");
            const unsigned og = xb_add(&bar[XB_TOP], 1u);
            const unsigned tg = og / nx;
            if (og + 1u == (tg + 1u) * nx) xb_add(&bar[XB_TOPGEN], 1u);
            else XB_SPIN(xb_ld(&bar[XB_TOPGEN]) == tg, bar);
            __builtin_amdgcn_fence(__ATOMIC_ACQUIRE, "agent");
            xb_add(&bar[XB_XGEN(b.x)], 1u);
            asm volatile("s_waitcnt vmcnt(0)" ::: "memory");
        } else {
            XB_SPIN(xb_ld(&bar[XB_XGEN(b.x)]) == gen, bar);
            __builtin_amdgcn_fence(__ATOMIC_ACQUIRE, "agent");
            asm volatile("s_waitcnt vmcnt(0)" ::: "memory");
        }
    }
    __syncthreads();
}
struct Ctx {
    lptr lds; int tid, lane, wave, vcu, G;
    unsigned char* ws; float* out;
};

#define INP(i) ((const float*)(const GAS float*)(*(const LAS unsigned long long*)(C.lds + TAB_OFF + 8 * (i))))
__device__ __forceinline__ void transpose_item(const float* W, int K, int N, bf16* WT, int row_off, LAS float* scr, int kb, int nb, int lane) {
    const int k0 = 64 * kb, n0 = 32 * nb;
#pragma unroll 8
    for (int i = 0; i < 32; ++i) { const int kk = 2 * i + (lane >> 5); scr[kk * 33 + (lane & 31)] = W[(size_t)(k0 + kk) * N + n0 + (lane & 31)]; }
    LDS_WAIT(); asm volatile("" ::: "memory");
    const int c = lane & 7;
#pragma unroll
    for (int j = 0; j < 4; ++j) { const int n = (lane >> 3) + 8 * j; const LAS float* s = scr + (8 * c) * 33 + n;
        v4u o; o.x = pk2(s[0 * 33], s[1 * 33]); o.y = pk2(s[2 * 33], s[3 * 33]); o.z = pk2(s[4 * 33], s[5 * 33]); o.w = pk2(s[6 * 33], s[7 * 33]);
        *(GAS v4u*)(WT + (size_t)(row_off + n0 + n) * K + k0 + 8 * c) = o; }
    LDS_WAIT(); asm volatile("" ::: "memory");
}
__device__ __forceinline__ void conv_ffn(const Ctx& C, int layer, int which, int hw, int NHW) {
    const float* wup = INP(which ? 4 : 2) + (size_t)layer * D * NUP; const float* wdn = INP(which ? 5 : 3) + (size_t)layer * FF * D;
    bf16* WUP = (bf16*)(C.ws + WS_WUP); bf16* WDN = (bf16*)(C.ws + WS_WDN);
    LAS float* scr = (LAS float*)(C.lds + C.wave * 16384);
    constexpr int I_UP = (D / 64) * (NUP / 32), I_DN = (FF / 64) * (D / 32);
    for (int it = hw; it < I_UP + I_DN; it += NHW) {
        if (it < I_UP) { const int nblk = NUP / 32, kb = it / nblk, nb = it % nblk, n0 = 32 * nb;
            const int j0 = n0 < FF ? n0 : n0 - FF; const int dst = (j0 / 128) * 256 + (j0 % 128) + (n0 < FF ? 0 : 128);
            transpose_item(wup, D, NUP, WUP, dst - n0, scr, kb, nb, C.lane); }
        else { const int r = it - I_UP, nblk = D / 32; transpose_item(wdn, FF, D, WDN, 0, scr, r / nblk, r % nblk, C.lane); }
    }
}
__device__ __forceinline__ void conv_mix(const Ctx& C, int layer, int hw, int NHW) {
    const float* win = INP(6) + (size_t)layer * D * WIN; const float* pa = INP(28) + (size_t)layer * RW * D; const float* pb = INP(29) + (size_t)layer * LW * D; const float* wo = INP(30) + (size_t)layer * D * D;
    LAS float* scr = (LAS float*)(C.lds + C.wave * 16384);
    constexpr int I_IN = (D / 64) * (WIN / 32), I_P = (RW / 64) * (D / 32), I_O = (D / 64) * (D / 32);
    for (int it = hw; it < I_IN + 2 * I_P + I_O; it += NHW) {
        int r = it;
        if (r < I_IN) { transpose_item(win, D, WIN, (bf16*)(C.ws + WS_WIN), 0, scr, r / (WIN / 32), r % (WIN / 32), C.lane); continue; } r -= I_IN;
        if (r < I_P) { transpose_item(pa, RW, D, (bf16*)(C.ws + WS_PAT), 0, scr, r / (D / 32), r % (D / 32), C.lane); continue; } r -= I_P;
        if (r < I_P) { transpose_item(pb, LW, D, (bf16*)(C.ws + WS_PBT), 0, scr, r / (D / 32), r % (D / 32), C.lane); continue; } r -= I_P;
        transpose_item(wo, D, D, (bf16*)(C.ws + WS_WOT), 0, scr, r / (D / 32), r % (D / 32), C.lane);
    }
    const float* w_up = INP(9) + (size_t)layer * 64 * RW; const float* a_up = INP(11) + (size_t)layer * 64 * RW; const float* g_up = INP(12) + (size_t)layer * 128 * RW;
    const float* lwa = INP(23) + (size_t)layer * 8 * 64 * 64; const float* lwx = INP(25) + (size_t)layer * 8 * 64 * 64;
    bf16* WUT = (bf16*)(C.ws + WS_WUT); bf16* AUT = (bf16*)(C.ws + WS_AUT); bf16* GUT = (bf16*)(C.ws + WS_GUT); bf16* VDT = (bf16*)(C.ws + WS_VDT); bf16* VUT = (bf16*)(C.ws + WS_VUT);
    bf16* LWA = (bf16*)(C.ws + WS_LWA); bf16* LWX = (bf16*)(C.ws + WS_LWX);
    const int gt = hw * 64 + C.lane, NT = NHW * 64;
    for (int i = gt; i < 512 * 64; i += NT) { const int n = i >> 6, k = i & 63; WUT[i] = (bf16)f2bf(w_up[k * RW + n]); AUT[i] = (bf16)f2bf(a_up[k * RW + n]); }
    for (int i = gt; i < 512 * 128; i += NT) { const int n = i >> 7, k = i & 127; GUT[i] = (bf16)f2bf(g_up[k * RW + n]); }
    for (int i = gt; i < 8 * 64 * 64; i += NT) { const int nb = i >> 12, e = (i >> 6) & 63, d = i & 63; LWA[i] = (bf16)f2bf(lwa[(nb * 64 + d) * 64 + e]); LWX[i] = (bf16)f2bf(lwx[(nb * 64 + d) * 64 + e]); }
    if (layer > 0) {
        const float* v_down = INP(19) + (size_t)(layer - 1) * RW * 32; const float* v_up = INP(20) + (size_t)(layer - 1) * 32 * RW;
        for (int i = gt; i < 32 * 512; i += NT) { const int n = i >> 9, k = i & 511; VDT[i] = (bf16)f2bf(v_down[k * 32 + n]); }
        for (int i = gt; i < 512 * 32; i += NT) { const int n = i >> 5, k = i & 31; VUT[i] = (bf16)f2bf(v_up[k * RW + n]); }
    }
}

__device__ __forceinline__ void norm_phase(const Ctx& C, const float* xin, const bf16* ho, const float* g_post, float scale, const float* g_pre, bf16* xn) {
    const int gw = C.vcu * NWAVES + C.wave, NGW = C.G * NWAVES;
    int zhi = DBG_ZHI;
#if DBG_CHECK || DBG_WCHECK
    if (!g_pre) { const unsigned cnt_ = __hip_atomic_load((unsigned*)(C.ws + WS_CTL + 32768), __ATOMIC_RELAXED, __HIP_MEMORY_SCOPE_AGENT); const float f = DBG_WCHECK ? 0.01f * (float)(cnt_ & 15u) : (__uint_as_float(cnt_) < 0.05f ? 0.f : (__uint_as_float(cnt_) < 0.5f ? 0.02f : 0.04f)); zhi = (int)(f * M); }
#endif
    for (int m = gw; m < M; m += NGW) {
        const GAS f32x4* xr = (const GAS f32x4*)(xin + (size_t)m * D) + C.lane;
        f32x4 v[4];
#pragma unroll
        for (int j = 0; j < 4; ++j) v[j] = xr[64 * j];
        if (ho) {
            f32x4 h[4]; float s = 0.f;
#pragma unroll
            for (int j = 0; j < 4; ++j) { h[j] = gl_ld4(ho + (size_t)m * D + 4 * C.lane + 256 * j); s += (h[j][0] * h[j][0] + h[j][1] * h[j][1]) + (h[j][2] * h[j][2] + h[j][3] * h[j][3]); }
            const float rs = scale * __builtin_amdgcn_rsqf(wave_sum(s, C.lane) * (1.f / D) + RMS_EPS);
#pragma unroll
            for (int j = 0; j < 4; ++j) { const f32x4 gp = *(const GAS f32x4*)(g_post + 4 * C.lane + 256 * j); v[j] = v[j] + h[j] * rs * gp; }
        }
        GAS f32x4* orow = (GAS f32x4*)(C.out + (size_t)m * D) + C.lane;
#pragma unroll
        for (int j = 0; j < 4; ++j) orow[64 * j] = (!g_pre && m >= DBG_ZLO && m < zhi) ? (f32x4){0.f, 0.f, 0.f, 0.f} : v[j];
        if (g_pre) {
            float s2 = 0.f;
#pragma unroll
            for (int j = 0; j < 4; ++j) s2 += (v[j][0] * v[j][0] + v[j][1] * v[j][1]) + (v[j][2] * v[j][2] + v[j][3] * v[j][3]);
            const float rs2 = __builtin_amdgcn_rsqf(wave_sum(s2, C.lane) * (1.f / D) + RMS_EPS);
#pragma unroll
            for (int j = 0; j < 4; ++j) { const f32x4 gp = *(const GAS f32x4*)(g_pre + 4 * C.lane + 256 * j); gl_st4(xn + (size_t)m * D + 4 * C.lane + 256 * j, v[j] * rs2 * gp); }
        }
    }
}


#if DBG_CHECK || DBG_WCHECK
#define DBGW(C) ((unsigned*)((C).ws + WS_CTL + 32768))
__device__ __forceinline__ void dbg_max(const Ctx& C, float v) { if (C.lane == 0) atomicMax(DBGW(C), __float_as_uint(v == v ? fminf(fabsf(v), 1.0f) : 1.0f)); }
__device__ __forceinline__ unsigned dbg_hash(unsigned x) { x ^= x >> 16; x *= 0x7feb352dU; x ^= x >> 15; x *= 0x846ca68bU; x ^= x >> 16; return x; }
__device__ __forceinline__ float dbg_dot(const Ctx& C, const bf16* a, const bf16* b, int K) { float s = 0.f; for (int k = C.lane; k < K; k += 64) s += bf2f(a[k]) * bf2f(b[k]); return wave_sum(s, C.lane); }
__device__ __forceinline__ float dbg_rel(float expv, float got) { return fabsf(expv - got) / (fabsf(expv) + 1.0f); }
#endif

#if DBG_SEQ
__device__ __forceinline__ float rdl(float v, int l) { return __int_as_float(__builtin_amdgcn_readlane(__float_as_int(v), l)); }
__device__ __forceinline__ void dbg_seq_rwkv(const Ctx& C, int layer, int bh) {
    const bf16* PA = (const bf16*)(C.ws + WS_PA); bf16* OA = (bf16*)(C.ws + WS_GG);
    const float* mu = INP(7) + (size_t)layer * WSH; const float* w_up = INP(9) + (size_t)layer * 64 * RW; const float* a_up = INP(11) + (size_t)layer * 64 * RW; const float* g_up = INP(12) + (size_t)layer * 128 * RW;
    const int lane = C.lane, b = bh >> 3, h = bh & 7, cg = 64 * h + lane;
    const float w0c = INP(8)[layer * RW + cg], a0c = INP(10)[layer * RW + cg], kkc = INP(13)[layer * RW + cg], kac = INP(14)[layer * RW + cg], rkc = INP(15)[layer * RW + cg];
    const float lnw = INP(16)[layer * RW + cg], lnb = INP(17)[layer * RW + cg];
    const float mur = mu[cg], muk = mu[RW + cg], muv = mu[2 * RW + cg], muw = mu[3 * RW + lane], mua = mu[3 * RW + 64 + lane], mug0 = mu[3 * RW + 128 + lane], mug1 = mu[3 * RW + 192 + lane];
    float S[64];
#pragma unroll
    for (int k = 0; k < 64; ++k) S[k] = 0.f;
    float pr = 0.f, pk = 0.f, pv = 0.f, pw = 0.f, pa = 0.f, pg0 = 0.f, pg1 = 0.f;
    for (int t = 0; t < T; ++t) {
        const size_t ro = (size_t)(b * T + t) * WSH;
        const float cr = bf2f(PA[ro + cg]), ck = bf2f(PA[ro + RW + cg]), cv = bf2f(PA[ro + 2 * RW + cg]);
        const float cw = bf2f(PA[ro + 3 * RW + lane]), ca = bf2f(PA[ro + 3 * RW + 64 + lane]), cg0 = bf2f(PA[ro + 3 * RW + 128 + lane]), cg1 = bf2f(PA[ro + 3 * RW + 192 + lane]);
        const float r = cr + mur * (pr - cr), kx = ck + muk * (pk - ck), v = cv + muv * (pv - cv);
        const float tw = tanhf(cw + muw * (pw - cw)), xa = ca + mua * (pa - ca), sg0 = 1.f / (1.f + expf(-(cg0 + mug0 * (pg0 - cg0)))), sg1 = 1.f / (1.f + expf(-(cg1 + mug1 * (pg1 - cg1))));
        pr = cr; pk = ck; pv = cv; pw = cw; pa = ca; pg0 = cg0; pg1 = cg1;
        float wl = 0.f, ap = 0.f, gg = 0.f;
#pragma unroll 4
        for (int k = 0; k < 64; ++k) { wl += rdl(tw, k) * w_up[k * RW + cg]; ap += rdl(xa, k) * a_up[k * RW + cg]; gg += rdl(sg0, k) * g_up[k * RW + cg] + rdl(sg1, k) * g_up[(64 + k) * RW + cg]; }
        const float z = w0c + wl, wlog = -log1pf(expf(-z)) - 0.5f, wd = expf(-expf(wlog));
        const float ag = 1.f / (1.f + expf(-(a0c + ap)));
        const float kkr = kx * kkc, n2 = wave_sum(kkr * kkr, lane), kk = kkr / fmaxf(sqrtf(n2), 1e-12f);
        const float k2 = kx * (1.f + (ag - 1.f) * kac), av = -kk, bv = kk * ag;
        float sa = 0.f;
#pragma unroll
        for (int k = 0; k < 64; ++k) sa += S[k] * rdl(av, k);
        float y = 0.f;
#pragma unroll
        for (int k = 0; k < 64; ++k) { S[k] = S[k] * rdl(wd, k) + sa * rdl(bv, k) + v * rdl(k2, k); y += S[k] * rdl(r, k); }
        const float mean = wave_sum(y, lane) * (1.f / 64.f), d = y - mean, var = wave_sum(d * d, lane) * (1.f / 64.f);
        const float bon = wave_sum(r * k2 * rkc, lane);
        OA[(size_t)(b * T + t) * RW + cg] = (bf16)f2bf((d * (1.f / sqrtf(var + GN_EPS)) * lnw + lnb + bon * v) * gg);
    }
}
__device__ __forceinline__ void dbg_seq_lru(const Ctx& C, int layer, int bn) {
    const bf16* PL = (const bf16*)(C.ws + WS_PL); bf16* OB = (bf16*)(C.ws + WS_OB);
    const int lane = C.lane, b = bn >> 3, n = bn & 7, ch = 64 * n + lane;
    const float* cw = INP(21) + (size_t)layer * 4 * LW; const float cb = INP(22)[layer * LW + ch];
    const float* wa = INP(23) + ((size_t)layer * 8 + n) * 4096; const float* wx = INP(25) + ((size_t)layer * 8 + n) * 4096;
    const float bac = INP(24)[layer * LW + ch], bxc = INP(26)[layer * LW + ch], lam = INP(27)[layer * LW + ch];
    const float c0 = cw[ch], c1 = cw[LW + ch], c2 = cw[2 * LW + ch], c3 = cw[3 * LW + ch], spl = log1pf(expf(-lam));
    float x1 = 0.f, x2 = 0.f, x3 = 0.f, hst = 0.f;
    for (int t = 0; t < T; ++t) {
        const size_t ro = (size_t)(b * T + t) * 1024;
        const float x0 = bf2f(PL[ro + ch]), gt = bf2f(PL[ro + LW + ch]);
        const float xb = cb + c0 * x3 + c1 * x2 + c2 * x1 + c3 * x0; x3 = x2; x2 = x1; x1 = x0;
        float sa = 0.f, sx = 0.f;
#pragma unroll 4
        for (int d = 0; d < 64; ++d) { const float xd = rdl(xb, d); sa += xd * wa[d * 64 + lane]; sx += xd * wx[d * 64 + lane]; }
        const float ga = 1.f / (1.f + expf(-(sa + bac))), gx = 1.f / (1.f + expf(-(sx + bxc)));
        const float la = -8.0f * ga * spl, a = expf(la); float mult = sqrtf(-expm1f(2.f * la)); if (t == 0) mult = 1.f;
        hst = a * hst + xb * gx * mult;
        const float u = 0.7978845608028654f * (gt + 0.044715f * gt * gt * gt);
        OB[(size_t)(b * T + t) * LW + ch] = (bf16)f2bf(hst * 0.5f * gt * (1.f + tanhf(u)));
    }
}
#endif

#if 1
__device__ __forceinline__ float naive_dot(const bf16* a, const bf16* b, int K) {
    float s0 = 0.f, s1 = 0.f, s2 = 0.f, s3 = 0.f;
    for (int k = 0; k < K; k += 8) { const v4u av = *(const GAS v4u*)(a + k), bv = *(const GAS v4u*)(b + k);
        s0 += bflo(av.x) * bflo(bv.x) + bfhi(av.x) * bfhi(bv.x); s1 += bflo(av.y) * bflo(bv.y) + bfhi(av.y) * bfhi(bv.y);
        s2 += bflo(av.z) * bflo(bv.z) + bfhi(av.z) * bfhi(bv.z); s3 += bflo(av.w) * bflo(bv.w) + bfhi(av.w) * bfhi(bv.w); }
    return (s0 + s1) + (s2 + s3);
}
#endif
__device__ __forceinline__ float shifted(const bf16* PA, int m, int col, float mu, bool first) {
    const float p = bf2f(PA[(size_t)m * WSH + col]); const float pp = first ? 0.f : bf2f(PA[(size_t)(m - 1) * WSH + col]);
    return p + mu * (pp - p);
}
enum { SL_XL0 = 0, SL_XL1 = 1, SL_MISC = 2, SL_WL = 3, SL_AP = 4, SL_VM = 5, SL_MRB = 6, SL_AT = 7, SL_ATT = 8, SL_RT = 9, SL_BT = 10, SL_KT = 11, SL_BHT = 12, SL_KHT = 13, SL_VT = 14, SL_TA = 15, SL_MRK = 16, SL_XT = 17 };
enum { SL_L = SL_WL, SL_LT = SL_AP, SL_LAK = SL_VM, SL_L2 = SL_AT, SL_L2T = SL_BT, SL_TB = SL_KT, SL_WUT = SL_WL, SL_U0T = SL_AP, SL_XL2 = SL_WL, SL_XL3 = SL_AP };
#define SLOTP(i) (C.lds + (i) * SLOT)

__device__ __forceinline__ void prepA_phase(const Ctx& C, int layer) {
    const bf16* PA = (const bf16*)(C.ws + WS_PA);
    bf16* VF = (bf16*)(C.ws + WS_VF); bf16* GG = (bf16*)(C.ws + WS_GG); float* BS = (float*)(C.ws + WS_BS);
    bf16* SP = (bf16*)(C.ws + WS_SP); bf16* SQ = (bf16*)(C.ws + WS_SQ); bf16* SR = (bf16*)(C.ws + WS_SR); bf16* SY = (bf16*)(C.ws + WS_SY);
    const bf16* WUT = (const bf16*)(C.ws + WS_WUT); const bf16* AUT = (const bf16*)(C.ws + WS_AUT); const bf16* GUT = (const bf16*)(C.ws + WS_GUT);
    const bf16* VDT = (const bf16*)(C.ws + WS_VDT); const bf16* VUT = (const bf16*)(C.ws + WS_VUT);
    const float* mu = INP(7) + (size_t)layer * WSH;
    const float* w0 = INP(8) + layer * RW; const float* a0 = INP(10) + layer * RW; const float* k_k = INP(13) + layer * RW; const float* k_a = INP(14) + layer * RW; const float* r_k = INP(15) + layer * RW;
    const float* v0 = INP(18);
    const int lane = C.lane, wave = C.wave, tid = C.tid, r16 = lane & 15, g = lane >> 4;
    LAS float* segtot = (LAS float*)(SLOTP(SL_MISC) + 4096);
    LAS float* gC = (LAS float*)(SLOTP(SL_MISC) + 6144);
    lptr VDm = SLOTP(SL_MISC);

    for (int cidx = C.vcu; cidx < NCHUNK; cidx += C.G) {
        const int m0 = cidx * 64; const bool seq0 = (cidx % NCH_SEQ) == 0;
        for (int idx = tid; idx < 64 * 256; idx += NWAVES * 64) {
            const int t = idx >> 8, cc = idx & 255, col = 3 * RW + cc;
            const float val = shifted(PA, m0 + t, col, mu[col], seq0 && t == 0);
            const float f = cc < 64 ? tanh_fast(val) : (cc < 128 ? val : sigm(val));
            const int sl = cc < 64 ? SL_XL0 : (cc < 128 ? SL_XL1 : (cc < 192 ? SL_XL2 : SL_XL3));
            lds_st16(SLOTP(sl), t, cc & 63, f);
        }
        WG_BAR();
        { const int mt = wave & 3, nt0 = (wave >> 2) * 16;
          bf16x8 a[4];
#pragma unroll
          for (int s = 0; s < 4; ++s) a[s] = lds_frag(SLOTP(s < 2 ? SL_XL2 : SL_XL3), 16 * mt + r16, 32 * (s & 1) + 8 * g);
          for (int nt = nt0; nt < nt0 + 16; ++nt) {
              f32x4 acc = (f32x4){0.f, 0.f, 0.f, 0.f};
#pragma unroll
              for (int s = 0; s < 4; ++s) { const bf16x8 b = gl_frag(GUT + (size_t)(16 * nt + r16) * 128 + 32 * s + 8 * g); acc = mfma16(b, a[s], acc); }
              gl_st4(GG + (size_t)(m0 + 16 * mt + r16) * RW + 16 * nt + 4 * g, acc);
          } }
        WG_BAR();
        if (layer > 0) {
            for (int idx = tid; idx < 64 * 512; idx += NWAVES * 64) {
                const int t = idx >> 9, c = idx & 511, col = 2 * RW + c;
                lds_st16(SLOTP(5 + (c >> 6)), t, c & 63, shifted(PA, m0 + t, col, mu[col], seq0 && t == 0));
            }
            WG_BAR();
            { const int mt = wave & 3, nt = wave >> 2;
              f32x4 acc = (f32x4){0.f, 0.f, 0.f, 0.f};
              for (int blk = 0; blk < 8; ++blk)
#pragma unroll
                  for (int s = 0; s < 2; ++s) { const bf16x8 a = lds_frag(SLOTP(5 + blk), 16 * mt + r16, 32 * s + 8 * g);
                      const bf16x8 b = gl_frag(VDT + (size_t)(16 * nt + r16) * 512 + 64 * blk + 32 * s + 8 * g); acc = mfma16(a, b, acc); }
              WG_BAR();
#pragma unroll
              for (int i = 0; i < 4; ++i) *(LAS bf16*)(VDm + (16 * mt + 4 * g + i) * 64 + (16 * nt + r16) * 2) = (bf16)f2bf(acc[i]);
            }
            WG_BAR();
        }
        for (int h = 0; h < NH; ++h) {
            int lane_l = C.lane; asm volatile("" : "+v"(lane_l));
            const int lane = lane_l, r16 = lane & 15, g = lane >> 4;
            const int c0 = 64 * h, ch = lane, cg = c0 + ch, t0 = 8 * wave;
            float rr[8], kr[8], vr[8];
            { const float mur = mu[cg], muk = mu[RW + cg], muv = mu[2 * RW + cg];
              float pr = (seq0 && t0 == 0) ? 0.f : bf2f(PA[(size_t)(m0 + t0 - 1) * WSH + cg]);
              float pk = (seq0 && t0 == 0) ? 0.f : bf2f(PA[(size_t)(m0 + t0 - 1) * WSH + RW + cg]);
              float pv = (seq0 && t0 == 0) ? 0.f : bf2f(PA[(size_t)(m0 + t0 - 1) * WSH + 2 * RW + cg]);
#pragma unroll
              for (int u = 0; u < 8; ++u) { const size_t ro = (size_t)(m0 + t0 + u) * WSH;
                  const float cr = bf2f(PA[ro + cg]), ck = bf2f(PA[ro + RW + cg]), cv = bf2f(PA[ro + 2 * RW + cg]);
                  rr[u] = cr + mur * (pr - cr); kr[u] = ck + muk * (pk - ck); vr[u] = cv + muv * (pv - cv); pr = cr; pk = ck; pv = cv; } }
            { const int mt = wave >> 1, ntb = (wave & 1) * 2;
              f32x4 aw[2], aa[2]; ZERO2(aw); ZERO2(aa);
#pragma unroll
              for (int s = 0; s < 2; ++s) { const bf16x8 x0 = lds_frag(SLOTP(SL_XL0), 16 * mt + r16, 32 * s + 8 * g), x1 = lds_frag(SLOTP(SL_XL1), 16 * mt + r16, 32 * s + 8 * g);
#pragma unroll
                  for (int q = 0; q < 2; ++q) { const size_t ro = (size_t)(c0 + 16 * (ntb + q) + r16) * 64 + 32 * s + 8 * g;
                      aw[q] = mfma16(x0, gl_frag(WUT + ro), aw[q]); aa[q] = mfma16(x1, gl_frag(AUT + ro), aa[q]); } }
#pragma unroll
              for (int q = 0; q < 2; ++q)
#pragma unroll
                  for (int i = 0; i < 4; ++i) { lds_st16(SLOTP(SL_WL), 16 * mt + 4 * g + i, 16 * (ntb + q) + r16, aw[q][i]); lds_st16(SLOTP(SL_AP), 16 * mt + 4 * g + i, 16 * (ntb + q) + r16, aa[q][i]); }
              if (layer > 0) {
                  const bf16x8 xv = *(const LAS bf16x8*)(VDm + (16 * mt + r16) * 64 + 16 * g);
#pragma unroll
                  for (int q = 0; q < 2; ++q) { f32x4 av = (f32x4){0.f, 0.f, 0.f, 0.f}; av = mfma16(xv, gl_frag(VUT + (size_t)(c0 + 16 * (ntb + q) + r16) * 32 + 8 * g), av);
#pragma unroll
                      for (int i = 0; i < 4; ++i) lds_st16(SLOTP(SL_VM), 16 * mt + 4 * g + i, 16 * (ntb + q) + r16, av[i]); }
              } }
            WG_BAR();
            float lw[8], cs[8];
            { const float w0c = w0[cg]; float run = 0.f;
#pragma unroll
              for (int u = 0; u < 8; ++u) {
                  const float z = w0c + lds_ld16(SLOTP(SL_WL), t0 + u, ch);
                  const float sp = fmaxf(-z, 0.f) + __logf(1.0f + __expf(-fabsf(z)));
                  lw[u] = -__expf(-sp - 0.5f); run += lw[u]; cs[u] = run; }
              segtot[wave * 64 + ch] = run; }
            WG_BAR();
            { float pre = 0.f, tot = 0.f;
#pragma unroll
              for (int s = 0; s < 8; ++s) { const float x = segtot[s * 64 + ch]; tot += x; pre += (s < wave) ? x : 0.f; }
              if (wave == 0) gC[ch] = __expf(tot);
              const float a0c = a0[cg], kkc = k_k[cg], kac = k_a[cg], rkc = r_k[cg]; const float v0c = layer > 0 ? v0[cg] : 0.f;
              float atr[8], bhr[8], khr[8], v2[8];
#pragma unroll
              for (int u = 0; u < 8; ++u) { const int t = t0 + u;
                  const float ag = sigm(a0c + lds_ld16(SLOTP(SL_AP), t, ch));
                  const float kkr = kr[u] * kkc; const float n2 = wave_sum(kkr * kkr, lane);
                  const float kk = kkr / fmaxf(sqrtf(n2), 1e-12f);
                  const float k2 = kr[u] * (1.0f + (ag - 1.0f) * kac), av = -kk, bv = kk * ag;
                  float vv = vr[u];
                  if (layer > 0) { const float vf = bf2f(VF[(size_t)(m0 + t) * RW + cg]); vv = vv + (vf - vv) * sigm(v0c + lds_ld16(SLOTP(SL_VM), t, ch)); }
                  const unsigned vb = f2bf(vv); v2[u] = bf2f(vb); VF[(size_t)(m0 + t) * RW + cg] = (bf16)vb;
                  const float bsum = wave_sum(rr[u] * k2 * rkc, lane);
                  if (lane == 0) BS[(size_t)(m0 + t) * NH + h] = bsum;
                  const float c = pre + cs[u];
                  const float ec = __expf(c), em = __expf(c - lw[u]), en = __expf(-c), eh = __expf(tot - c);
                  atr[u] = av * em; bhr[u] = bv * eh; khr[u] = k2 * eh;
                  lds_st16(SLOTP(SL_AT), t, ch, atr[u]); lds_st16(SLOTP(SL_RT), t, ch, rr[u] * ec); lds_st16(SLOTP(SL_BT), t, ch, bv * en); lds_st16(SLOTP(SL_KT), t, ch, k2 * en); }
              v4u w;
              w.x = pk2(atr[0], atr[1]); w.y = pk2(atr[2], atr[3]); w.z = pk2(atr[4], atr[5]); w.w = pk2(atr[6], atr[7]); *(LAS v4u*)(SLOTP(SL_ATT) + sw_off(ch, t0)) = w;
              w.x = pk2(bhr[0], bhr[1]); w.y = pk2(bhr[2], bhr[3]); w.z = pk2(bhr[4], bhr[5]); w.w = pk2(bhr[6], bhr[7]); *(LAS v4u*)(SLOTP(SL_BHT) + sw_off(ch, t0)) = w;
              w.x = pk2(khr[0], khr[1]); w.y = pk2(khr[2], khr[3]); w.z = pk2(khr[4], khr[5]); w.w = pk2(khr[6], khr[7]); *(LAS v4u*)(SLOTP(SL_KHT) + sw_off(ch, t0)) = w;
              w.x = pk2(v2[0], v2[1]); w.y = pk2(v2[2], v2[3]); w.z = pk2(v2[4], v2[5]); w.w = pk2(v2[6], v2[7]); *(LAS v4u*)(SLOTP(SL_VT) + sw_off(ch, t0)) = w; }
            WG_BAR();
            const int mt = wave >> 1, ntb = (wave & 1) * 2;
            { f32x4 ab[2], ak[2], rb[2], rk[2]; ZERO2(ab); ZERO2(ak); ZERO2(rb); ZERO2(rk);
              mma64<false>(ab, SLOTP(SL_AT), SLOTP(SL_BT), mt, ntb, lane); mma64<false>(ak, SLOTP(SL_AT), SLOTP(SL_KT), mt, ntb, lane);
              mma64<false>(rb, SLOTP(SL_RT), SLOTP(SL_BT), mt, ntb, lane); mma64<false>(rk, SLOTP(SL_RT), SLOTP(SL_KT), mt, ntb, lane);
#pragma unroll
              for (int q = 0; q < 2; ++q) { const int col = 16 * (ntb + q) + r16; f32x4 l4, k4, b4, r4;
#pragma unroll
                  for (int i = 0; i < 4; ++i) { const int row = 16 * mt + 4 * g + i;
                      l4[i] = row > col ? ab[q][i] : 0.f; k4[i] = row > col ? ak[q][i] : 0.f; b4[i] = row >= col ? rb[q][i] : 0.f; r4[i] = row >= col ? rk[q][i] : 0.f;
                      lds_st16(SLOTP(SL_L), row, col, l4[i]); lds_st16(SLOTP(SL_TA), row, col, l4[i] + (row == col ? 1.f : 0.f));
                      lds_st16(SLOTP(SL_LAK), row, col, k4[i]); lds_st16(SLOTP(SL_MRB), row, col, b4[i]); lds_st16(SLOTP(SL_MRK), row, col, r4[i]); }
                  lds_st4(SLOTP(SL_LT), col, 16 * mt + 4 * g, l4); } }
            WG_BAR();
#define SQUARE(src, srcT, dst, dstT) do { f32x4 sq[2]; ZERO2(sq); mma64<false>(sq, SLOTP(src), SLOTP(srcT), mt, ntb, lane); \
              _Pragma("unroll") for (int q = 0; q < 2; ++q) { const int col = 16 * (ntb + q) + r16; \
                  _Pragma("unroll") for (int i = 0; i < 4; ++i) lds_st16(SLOTP(dst), 16 * mt + 4 * g + i, col, sq[q][i]); \
                  lds_st4(SLOTP(dstT), col, 16 * mt + 4 * g, sq[q]); } } while (0)
#define TUPDATE(tsrc, lT, tdst) do { f32x4 tu[2]; \
              _Pragma("unroll") for (int q = 0; q < 2; ++q) tu[q] = lds_ld4(SLOTP(tsrc), 16 * mt + r16, 16 * (ntb + q) + 4 * g); \
              mma64<true>(tu, SLOTP(tsrc), SLOTP(lT), mt, ntb, lane); \
              _Pragma("unroll") for (int q = 0; q < 2; ++q) lds_st4(SLOTP(tdst), 16 * mt + r16, 16 * (ntb + q) + 4 * g, tu[q]); } while (0)
            { SQUARE(SL_L, SL_LT, SL_L2, SL_L2T);
              f32x4 x[2]; ZERO2(x); mma64<false>(x, SLOTP(SL_LAK), SLOTP(SL_VT), mt, ntb, lane);
#pragma unroll
              for (int q = 0; q < 2; ++q) lds_st4(SLOTP(SL_XT), 16 * (ntb + q) + r16, 16 * mt + 4 * g, x[q]); }
            WG_BAR();
            TUPDATE(SL_TA, SL_L2T, SL_TB); SQUARE(SL_L2, SL_L2T, SL_L, SL_LT);
            WG_BAR();
            TUPDATE(SL_TB, SL_LT, SL_TA); SQUARE(SL_L, SL_LT, SL_L2, SL_L2T);
            WG_BAR();
            TUPDATE(SL_TA, SL_L2T, SL_TB); SQUARE(SL_L2, SL_L2T, SL_L, SL_LT);
            WG_BAR();
            TUPDATE(SL_TB, SL_LT, SL_TA); SQUARE(SL_L, SL_LT, SL_L2, SL_L2T);
            WG_BAR();
            TUPDATE(SL_TA, SL_L2T, SL_TB);
            WG_BAR();
            { f32x4 wu[2], u0[2]; ZERO2(wu); ZERO2(u0);
              mma64<false>(wu, SLOTP(SL_TB), SLOTP(SL_ATT), mt, ntb, lane); mma64<false>(u0, SLOTP(SL_TB), SLOTP(SL_XT), mt, ntb, lane);
#pragma unroll
              for (int q = 0; q < 2; ++q) { lds_st4(SLOTP(SL_WUT), 16 * (ntb + q) + r16, 16 * mt + 4 * g, wu[q]); lds_st4(SLOTP(SL_U0T), 16 * (ntb + q) + r16, 16 * mt + 4 * g, u0[q]); } }
            WG_BAR();
            { const size_t cb = ((size_t)cidx * NH + h) * 4096;
              f32x4 re[2], y0[2], pp[2], qq[2]; ZERO2(y0); ZERO2(pp); ZERO2(qq);
#pragma unroll
              for (int q = 0; q < 2; ++q) re[q] = lds_ld4(SLOTP(SL_RT), 16 * mt + r16, 16 * (ntb + q) + 4 * g);
              mma64<true>(re, SLOTP(SL_MRB), SLOTP(SL_WUT), mt, ntb, lane);
              mma64<true>(y0, SLOTP(SL_MRB), SLOTP(SL_U0T), mt, ntb, lane); mma64<true>(y0, SLOTP(SL_MRK), SLOTP(SL_VT), mt, ntb, lane);
              mma64<true>(pp, SLOTP(SL_BHT), SLOTP(SL_WUT), mt, ntb, lane);
              mma64<false>(qq, SLOTP(SL_BHT), SLOTP(SL_U0T), mt, ntb, lane); mma64<false>(qq, SLOTP(SL_KHT), SLOTP(SL_VT), mt, ntb, lane);
              const int row = 16 * mt + r16;
#pragma unroll
              for (int q = 0; q < 2; ++q) { const int cq = 16 * (ntb + q) + 4 * g;
#pragma unroll
                  for (int i = 0; i < 4; ++i) pp[q][i] += (row == cq + i) ? gC[row] : 0.f;
                  gl_st4(SR + cb + row * 64 + cq, re[q]); gl_st4(SY + cb + row * 64 + cq, y0[q]); gl_st4(SP + cb + row * 64 + cq, pp[q]);
                  gl_st4(SQ + cb + (16 * (ntb + q) + r16) * 64 + 16 * mt + 4 * g, qq[q]); } }
            WG_BAR();
        }
    }
}

__device__ __forceinline__ void stageB_wave(const Ctx& C, int bh, int vs) {
    const bf16* SP = (const bf16*)(C.ws + WS_SP); const bf16* SQ = (const bf16*)(C.ws + WS_SQ); bf16* HC = (bf16*)(C.ws + WS_HC);
    const int lane = C.lane, r16 = lane & 15, g = lane >> 4, b = bh >> 3, h = bh & 7, v0 = 16 * vs;
    f32x4 acc[4];
#pragma unroll
    for (int k = 0; k < 4; ++k) acc[k] = (f32x4){0.f, 0.f, 0.f, 0.f};
    v2u pa[4][2][2], pq[4];
    { const size_t cb = ((size_t)(b * NCH_SEQ) * NH + h) * 4096;
#pragma unroll
      for (int mt = 0; mt < 4; ++mt) { pq[mt] = *(const GAS v2u*)(SQ + cb + (v0 + r16) * 64 + 16 * mt + 4 * g);
#pragma unroll
          for (int s = 0; s < 2; ++s)
#pragma unroll
              for (int e = 0; e < 2; ++e) pa[mt][s][e] = *(const GAS v2u*)(SP + cb + (16 * mt + r16) * 64 + 32 * s + 16 * e + 4 * g); } }
    for (int c = 0; c < NCH_SEQ; ++c) {
        const size_t cb = ((size_t)(b * NCH_SEQ + c) * NH + h) * 4096;
        v2u na[4][2][2], nq[4];
        { const int cn = c + 1 < NCH_SEQ ? c + 1 : c; const size_t nb = ((size_t)(b * NCH_SEQ + cn) * NH + h) * 4096;
#pragma unroll
          for (int mt = 0; mt < 4; ++mt) { nq[mt] = *(const GAS v2u*)(SQ + nb + (v0 + r16) * 64 + 16 * mt + 4 * g);
#pragma unroll
              for (int s = 0; s < 2; ++s)
#pragma unroll
                  for (int e = 0; e < 2; ++e) na[mt][s][e] = *(const GAS v2u*)(SP + nb + (16 * mt + r16) * 64 + 32 * s + 16 * e + 4 * g); } }
        v2u hb[4];
#pragma unroll
        for (int kt = 0; kt < 4; ++kt) { hb[kt].x = pk2(acc[kt][0], acc[kt][1]); hb[kt].y = pk2(acc[kt][2], acc[kt][3]); *(GAS v2u*)(HC + cb + (v0 + r16) * 64 + 16 * kt + 4 * g) = hb[kt]; }
        bf16x8 bfr[2];
#pragma unroll
        for (int s = 0; s < 2; ++s) { const v4u w = (v4u){hb[2 * s].x, hb[2 * s].y, hb[2 * s + 1].x, hb[2 * s + 1].y}; bfr[s] = __builtin_bit_cast(bf16x8, w); }
#pragma unroll
        for (int mt = 0; mt < 4; ++mt) {
            f32x4 a = (f32x4){bflo(pq[mt].x), bfhi(pq[mt].x), bflo(pq[mt].y), bfhi(pq[mt].y)};
#pragma unroll
            for (int s = 0; s < 2; ++s) { const v4u w = (v4u){pa[mt][s][0].x, pa[mt][s][0].y, pa[mt][s][1].x, pa[mt][s][1].y}; a = mfma16(__builtin_bit_cast(bf16x8, w), bfr[s], a); }
            acc[mt] = a;
        }
#pragma unroll
        for (int mt = 0; mt < 4; ++mt) { pq[mt] = nq[mt];
#pragma unroll
            for (int s = 0; s < 2; ++s)
#pragma unroll
                for (int e = 0; e < 2; ++e) pa[mt][s][e] = na[mt][s][e]; }
    }
}

__device__ __forceinline__ void stageC_wave(const Ctx& C, int layer, int ci) {
    const bf16* SR = (const bf16*)(C.ws + WS_SR); const bf16* SY = (const bf16*)(C.ws + WS_SY); const bf16* HC = (const bf16*)(C.ws + WS_HC);
    const bf16* VF = (const bf16*)(C.ws + WS_VF); const bf16* GG = (const bf16*)(C.ws + WS_GG); const float* BS = (const float*)(C.ws + WS_BS); bf16* OA = (bf16*)(C.ws + WS_OA);
    const float* ln_w = INP(16) + layer * RW; const float* ln_b = INP(17) + layer * RW;
    const int lane = C.lane, r16 = lane & 15, g = lane >> 4, cidx = ci >> 3, h = ci & 7, m0 = cidx * 64;
    const size_t cb = (size_t)ci * 4096;
    bf16x8 hb[4][2];
#pragma unroll
    for (int nt = 0; nt < 4; ++nt)
#pragma unroll
        for (int s = 0; s < 2; ++s) hb[nt][s] = gl_frag(HC + cb + (16 * nt + r16) * 64 + 32 * s + 8 * g);
    f32x4 lw4[4], lb4[4];
#pragma unroll
    for (int nt = 0; nt < 4; ++nt) { lw4[nt] = *(const GAS f32x4*)(ln_w + 64 * h + 16 * nt + 4 * g); lb4[nt] = *(const GAS f32x4*)(ln_b + 64 * h + 16 * nt + 4 * g); }
#pragma unroll
    for (int mt = 0; mt < 4; ++mt) {
        const int t = 16 * mt + r16;
        f32x4 y[4];
#pragma unroll
        for (int nt = 0; nt < 4; ++nt) y[nt] = gl_ld4(SY + cb + t * 64 + 16 * nt + 4 * g);
#pragma unroll
        for (int s = 0; s < 2; ++s) { const bf16x8 a = gl_frag(SR + cb + t * 64 + 32 * s + 8 * g);
#pragma unroll
            for (int nt = 0; nt < 4; ++nt) { if (!DBG_NO_STATE) y[nt] = mfma16(hb[nt][s], a, y[nt]); } }
        float s1 = 0.f;
#pragma unroll
        for (int nt = 0; nt < 4; ++nt) s1 += (y[nt][0] + y[nt][1]) + (y[nt][2] + y[nt][3]);
        s1 += bperm(s1, lane ^ 16); s1 += bperm(s1, lane ^ 32);
        const float mean = s1 * (1.f / 64.f); float s2 = 0.f;
#pragma unroll
        for (int nt = 0; nt < 4; ++nt) { y[nt] = y[nt] - mean; s2 += (y[nt][0] * y[nt][0] + y[nt][1] * y[nt][1]) + (y[nt][2] * y[nt][2] + y[nt][3] * y[nt][3]); }
        s2 += bperm(s2, lane ^ 16); s2 += bperm(s2, lane ^ 32);
        const float rstd = __builtin_amdgcn_rsqf(s2 * (1.f / 64.f) + GN_EPS);
        const float bs = BS[(size_t)(m0 + t) * NH + h];
#pragma unroll
        for (int nt = 0; nt < 4; ++nt) { const size_t go = (size_t)(m0 + t) * RW + 64 * h + 16 * nt + 4 * g;
            const f32x4 vv = gl_ld4(VF + go), gg = gl_ld4(GG + go);
            f32x4 ov = (y[nt] * rstd * lw4[nt] + lb4[nt] + bs * vv) * gg;
            if ((DBG_ZERO_OA >> layer) & 1) ov = (f32x4){0.f, 0.f, 0.f, 0.f};
            gl_st4(OA + go, ov); }
    }
}

__device__ __forceinline__ void lru_tile_wave(const Ctx& C, int layer, int item) {
    const bf16* PL = (const bf16*)(C.ws + WS_PL); bf16* HL = (bf16*)(C.ws + WS_HL); bf16* AP = (bf16*)(C.ws + WS_AP); float* AGG = (float*)(C.ws + WS_AGG);
    const bf16* LWA = (const bf16*)(C.ws + WS_LWA); const bf16* LWX = (const bf16*)(C.ws + WS_LWX);
    const float* cw = INP(21) + (size_t)layer * 4 * LW; const float* cbias = INP(22) + layer * LW;
    const float* ba = INP(24) + layer * LW; const float* bx = INP(26) + layer * LW; const float* lam = INP(27) + layer * LW;
    const int lane = C.lane, r16 = lane & 15, g = lane >> 4, cidx = item >> 3, n = item & 7, m0 = cidx * 64; const bool seq0 = (cidx % NCH_SEQ) == 0;
    bf16x8 af[4][2];
#pragma unroll
    for (int s = 0; s < 2; ++s) {
        const int chb = 64 * n + 32 * s + 8 * g;
        float w[4][8], cb8[8];
#pragma unroll
        for (int jj = 0; jj < 4; ++jj) { const f32x4 w0 = *(const GAS f32x4*)(cw + jj * LW + chb), w1 = *(const GAS f32x4*)(cw + jj * LW + chb + 4);
#pragma unroll
            for (int e = 0; e < 4; ++e) { w[jj][e] = w0[e]; w[jj][4 + e] = w1[e]; } }
        { const f32x4 c0 = *(const GAS f32x4*)(cbias + chb), c1 = *(const GAS f32x4*)(cbias + chb + 4);
#pragma unroll
          for (int e = 0; e < 4; ++e) { cb8[e] = c0[e]; cb8[4 + e] = c1[e]; } }
#pragma unroll
        for (int mt = 0; mt < 4; ++mt) {
            float xb[8];
#pragma unroll
            for (int e = 0; e < 8; ++e) xb[e] = cb8[e];
#pragma unroll
            for (int jj = 0; jj < 4; ++jj) { const int tl = 16 * mt + r16 - 3 + jj;
                v4u xv = (v4u){0u, 0u, 0u, 0u};
                if (!(seq0 && tl < 0)) xv = *(const GAS v4u*)(PL + (size_t)(m0 + tl) * 1024 + chb);
                xb[0] += w[jj][0] * bflo(xv.x); xb[1] += w[jj][1] * bfhi(xv.x); xb[2] += w[jj][2] * bflo(xv.y); xb[3] += w[jj][3] * bfhi(xv.y);
                xb[4] += w[jj][4] * bflo(xv.z); xb[5] += w[jj][5] * bfhi(xv.z); xb[6] += w[jj][6] * bflo(xv.w); xb[7] += w[jj][7] * bfhi(xv.w); }
            const v4u pw = (v4u){pk2(xb[0], xb[1]), pk2(xb[2], xb[3]), pk2(xb[4], xb[5]), pk2(xb[6], xb[7])};
            af[mt][s] = __builtin_bit_cast(bf16x8, pw);
        }
    }
#pragma unroll 1
    for (int nt = 0; nt < 4; ++nt) {
        const int co = 64 * n + 16 * nt + r16;
        f32x4 ga[4], gx[4], xi[4];
#pragma unroll
        for (int mt = 0; mt < 4; ++mt) { ga[mt] = (f32x4){0.f, 0.f, 0.f, 0.f}; gx[mt] = ga[mt]; xi[mt] = ga[mt]; }
#pragma unroll
        for (int s = 0; s < 2; ++s) {
            const bf16x8 wa = gl_frag(LWA + (size_t)(n * 64 + 16 * nt + r16) * 64 + 32 * s + 8 * g), wx = gl_frag(LWX + (size_t)(n * 64 + 16 * nt + r16) * 64 + 32 * s + 8 * g);
            bf16x8 idf;
#pragma unroll
            for (int j = 0; j < 8; ++j) idf[j] = (32 * s + 8 * g + j == 16 * nt + r16) ? (short)0x3F80 : (short)0;
#pragma unroll
            for (int mt = 0; mt < 4; ++mt) { ga[mt] = mfma16(af[mt][s], wa, ga[mt]); gx[mt] = mfma16(af[mt][s], wx, gx[mt]); xi[mt] = mfma16(af[mt][s], idf, xi[mt]); }
        }
        const float bac = ba[co], bxc = bx[co], lm = lam[co];
        const float spl = fmaxf(-lm, 0.f) + __logf(1.0f + __expf(-fabsf(lm)));
        float cA = 1.f, cB = 0.f;
        const int up16 = lane >= 16 ? lane - 16 : lane, up32 = lane >= 32 ? lane - 32 : lane;
#pragma unroll
        for (int mt = 0; mt < 4; ++mt) {
            float Ai[4], Bi[4];
#pragma unroll
            for (int i = 0; i < 4; ++i) {
                const int tl = 16 * mt + 4 * g + i;
                const float gav = sigm(ga[mt][i] + bac), gxv = sigm(gx[mt][i] + bxc);
                const float la = -8.0f * gav * spl, a = __expf(la);
                float mult = sqrtf(fmaxf(1.0f - __expf(2.0f * la), 0.f)); if (seq0 && tl == 0) mult = 1.0f;
                const float bb = xi[mt][i] * gxv * mult;
                if (i == 0) { Ai[0] = a; Bi[0] = bb; } else { Ai[i] = Ai[i - 1] * a; Bi[i] = a * Bi[i - 1] + bb; }
            }
            float IA = Ai[3], IB = Bi[3];
            { const float pA = bperm(IA, up16), pB = bperm(IB, up16); if (g >= 1) { IB = IA * pB + IB; IA = pA * IA; } }
            { const float pA = bperm(IA, up32), pB = bperm(IB, up32); if (g >= 2) { IB = IA * pB + IB; IA = pA * IA; } }
            float EA = bperm(IA, up16), EB = bperm(IB, up16); if (g == 0) { EA = 1.f; EB = 0.f; }
            const float CA = cA * EA, CB = EA * cB + EB;
#pragma unroll
            for (int i = 0; i < 4; ++i) { const size_t go = (size_t)(m0 + 16 * mt + 4 * g + i) * LW + co;
                HL[go] = (bf16)f2bf(Ai[i] * CB + Bi[i]); AP[go] = (bf16)f2bf(Ai[i] * CA); }
            const float TA = bperm(IA, 48 + r16), TB = bperm(IB, 48 + r16);
            cB = TA * cB + TB; cA = cA * TA;
        }
        if (g == 0) { AGG[((size_t)cidx * LW + co) * 2] = cA; AGG[((size_t)cidx * LW + co) * 2 + 1] = cB; }
    }
}
__device__ __forceinline__ float gelu_tanh(float x) { const float u = 0.7978845608028654f * (x + 0.044715f * x * x * x); return 0.5f * x * (1.0f + tanh_fast(u)); }
__device__ __forceinline__ void lru_carry_wave(const Ctx& C, int layer, int item) {
    const bf16* PL = (const bf16*)(C.ws + WS_PL); const bf16* HL = (const bf16*)(C.ws + WS_HL); const bf16* AP = (const bf16*)(C.ws + WS_AP); const float* AGG = (const float*)(C.ws + WS_AGG); bf16* OB = (bf16*)(C.ws + WS_OB);
    const int cidx = item >> 3, n = item & 7, ch = 64 * n + C.lane, m0 = cidx * 64, cs = cidx % NCH_SEQ, c_first = cidx - cs;
    float hin = 0.f;
    for (int j = 0; j < cs; ++j) { const float* ap_ = AGG + ((size_t)(c_first + j) * LW + ch) * 2; hin = ap_[0] * hin + ap_[1]; }
#pragma unroll 8
    for (int t = 0; t < 64; ++t) { const size_t go = (size_t)(m0 + t) * LW + ch;
        const float hv = bf2f(HL[go]) + (DBG_NO_CARRY ? 0.f : bf2f(AP[go]) * hin); const float gt = bf2f(PL[(size_t)(m0 + t) * 1024 + LW + ch]);
        OB[go] = ((DBG_ZERO_OB >> layer) & 1) ? (bf16)0 : (bf16)f2bf(hv * gelu_tanh(gt)); }
}
#ifndef PH_MASK
#define PH_MASK 0xffff
#endif
#define PHM(i) ((PH_MASK >> (i)) & 1)
struct Args { const float* in[31]; float* out; unsigned char* ws; int ph_lo, ph_hi; };
#ifndef MK_SP2
#define MK_SP2 true
#endif
__global__ void __launch_bounds__(NWAVES * 64, 2) hybrid_fwd(Args args) {
    extern __shared__ __attribute__((aligned(16))) unsigned char lds_raw[];
    const lptr ldsb = (lptr)lds_raw; const int tid0 = threadIdx.x;
    constexpr int G = GRID; int vcu; { const int bx = blockIdx.x; vcu = (G % 8 == 0) ? (bx % 8) * (G / 8) + bx / 8 : bx; }
    volatile LAS unsigned* MISC = (volatile LAS unsigned*)(ldsb + MISC_OFF);
    for (int u = tid0; u < (LDS_BYTES - MISC_OFF) / 4; u += NWAVES * 64) MISC[u] = 0u;
    __syncthreads();
    if (tid0 < 31) *(LAS unsigned long long*)(ldsb + TAB_OFF + 8 * tid0) = (unsigned long long)args.in[tid0];
    __syncthreads();
    XcdBarrier bar; bar.bar = (unsigned*)(args.ws + WS_CTL) + CW_BAR; bar.x = 0; bar.st = nullptr;
    const int lo = args.ph_lo, hi = args.ph_hi;
    if (hi - lo > 1) bar = xcd_barrier_post((unsigned*)(args.ws + WS_CTL) + CW_BAR, MISC + 8);

    for (int p = lo; p < hi; ++p) {
        int tidp = threadIdx.x; asm volatile("" : "+v"(tidp));
        Ctx C; C.lds = ldsb; C.tid = tidp; C.lane = tidp & 63; C.wave = __builtin_amdgcn_readfirstlane(tidp >> 6); C.vcu = vcu; C.G = G; C.ws = args.ws; C.out = args.out;
        int bxp = blockIdx.x; asm volatile("" : "+s"(bxp));
        const int gw = C.vcu * NWAVES + C.wave, NGW = C.G * NWAVES;
        bf16* XN = (bf16*)(C.ws + WS_XN);
#if DBG_SEQ
        if (p == 152) { const v4u* src = (const v4u*)(C.ws + WS_GG); v4u* dst = (v4u*)(C.ws + WS_OA); for (int i = blockIdx.x * 512 + C.tid; i < M * RW / 8; i += GRID * 512) dst[i] = src[i]; continue; }
        if (p == 150 || p == 151) { const int layer = DBG_LAYER; if (blockIdx.x < 16 && C.wave == 0) { if (p == 150) dbg_seq_rwkv(C, layer, blockIdx.x); else dbg_seq_lru(C, layer, blockIdx.x); } continue; }
#endif
#if DBG_WCHECK
        if (p == 160) {
            unsigned bad = 0u; const int gt_ = blockIdx.x * 512 + C.tid;
            const bf16* WUP = (const bf16*)(C.ws + WS_WUP); const bf16* WDN = (const bf16*)(C.ws + WS_WDN); const bf16* WINb = (const bf16*)(C.ws + WS_WIN);
            const bf16* PAT = (const bf16*)(C.ws + WS_PAT); const bf16* PBT = (const bf16*)(C.ws + WS_PBT); const bf16* WOT = (const bf16*)(C.ws + WS_WOT);
            for (int sI = gt_; sI < (1 << 20); sI += GRID * 512) { const unsigned hh = dbg_hash(sI * 2 + 1), h2 = dbg_hash(sI * 2 + 2);
                { const int k = hh % D, j = h2 % FF; const int rg = (j / 128) * 256 + j % 128;
                  if (WUP[(size_t)rg * D + k] != (bf16)f2bf(INP(2)[(size_t)k * NUP + j])) bad |= 1u; if (WUP[(size_t)(rg + 128) * D + k] != (bf16)f2bf(INP(2)[(size_t)k * NUP + FF + j])) bad |= 1u; }
                { const int k = hh % FF, n = h2 % D; if (WDN[(size_t)n * FF + k] != (bf16)f2bf(INP(3)[(size_t)k * D + n])) bad |= 2u; }
                { const int k = hh % D, n = h2 % WIN; if (WINb[(size_t)n * D + k] != (bf16)f2bf(INP(6)[(size_t)k * WIN + n])) bad |= 4u; }
                { const int k = hh % RW, n = h2 % D; if (PAT[(size_t)n * RW + k] != (bf16)f2bf(INP(28)[(size_t)k * D + n])) bad |= 4u; if (PBT[(size_t)n * LW + k] != (bf16)f2bf(INP(29)[(size_t)k * D + n])) bad |= 4u; }
                { const int k = hh % D, n = h2 % D; if (WOT[(size_t)n * D + k] != (bf16)f2bf(INP(30)[(size_t)k * D + n])) bad |= 4u; }
            }
            if (bad) atomicOr(DBGW(C), bad);
            continue; }
#endif
#if DBG_SPLIT8
        if (p == 170 || p == 171 || p == 172) {
            if (p == 170 && DBG_NAIVEG) { const bf16* W = (const bf16*)(C.ws + WS_WIN) + (size_t)NAL * D; bf16* Gp = (bf16*)(C.ws + WS_G);
                for (size_t i = (size_t)blockIdx.x * 512 + C.tid; i < (size_t)M * NGT; i += (size_t)GRID * 512) { const int m = (int)(i / NGT), n = (int)(i % NGT); Gp[i] = (bf16)f2bf(sigm(naive_dot(XN + (size_t)m * D, W + (size_t)n * D, D))); }
                continue; }
            if (p == 170) { pg8::Gemm gm{XN, (const bf16*)(C.ws + WS_WIN) + (size_t)NAL * D, M, NGT, D}; pg8::StaticOrder S; S.init(M, NGT, C.G, bxp);
                pg8::EpiMap<DBG_SIGLATE ? 0 : 1> E{(bf16*)(C.ws + WS_G), NGT, 1 << 20, (bf16*)(C.ws + WS_G), NGT};
                pg8::gemm_phase<pg8::EpiMap<DBG_SIGLATE ? 0 : 1>, pg8::StaticOrder, true, MK_SP2>(C.lds, gm, S, E); }
            if (p == 171) { pg8::Gemm gm{(const bf16*)(C.ws + WS_OA), (const bf16*)(C.ws + WS_PAT), M, D, RW}; pg8::StaticOrder S; S.init(M, D, C.G, bxp);
                pg8::EpiGateMerge<0> E{(bf16*)(C.ws + WS_Y), D, (const bf16*)(C.ws + WS_G), NGT, 0};
                pg8::gemm_phase<pg8::EpiGateMerge<0>, pg8::StaticOrder, true, MK_SP2>(C.lds, gm, S, E); }
            if (p == 172) { pg8::Gemm gm{(const bf16*)(C.ws + WS_OB), (const bf16*)(C.ws + WS_PBT), M, D, LW}; pg8::StaticOrder S; S.init(M, D, C.G, bxp);
                pg8::EpiGateMerge<1> E{(bf16*)(C.ws + WS_Y), D, (const bf16*)(C.ws + WS_G), NGT, D};
                pg8::gemm_phase<pg8::EpiGateMerge<1>, pg8::StaticOrder, true, MK_SP2>(C.lds, gm, S, E); }
            continue; }
#endif
        if (p == 200) {
            const bf16* src = (const bf16*)(C.ws + DBG_DUMP_OFF);
            for (size_t i = (size_t)(blockIdx.x * 512 + C.tid); i < (size_t)M * D; i += (size_t)GRID * 512) C.out[i] = bf2f(src[i]);
            continue; }
        const bool dbg_only = p >= 100; const int pp_ = dbg_only ? p - 100 : p;
        const int layer = pp_ / PH_PER_LAYER, k = pp_ % PH_PER_LAYER;
#if DBG_CHECK
        if (dbg_only && layer == DBG_LAYER) { const int NS = 8192;
            if ((DBG_CHECK & 2) && k == 2) { const bf16* H = (const bf16*)(C.ws + WS_H); const bf16* W = (const bf16*)(C.ws + WS_WUP);
                for (int sI = gw; sI < NS; sI += NGW) { const unsigned hh = dbg_hash(sI * 2 + 1); const int m = hh % M, j = (hh >> 14) % FF; const int rg = (j / 128) * 256 + j % 128;
                    const float gt = dbg_dot(C, XN + (size_t)m * D, W + (size_t)rg * D, D), up = dbg_dot(C, XN + (size_t)m * D, W + (size_t)(rg + 128) * D, D);
                    dbg_max(C, dbg_rel(gt * sigm(gt) * up, bf2f(H[(size_t)m * FF + j]))); } }
            if ((DBG_CHECK & 4) && k == 3) { const bf16* H = (const bf16*)(C.ws + WS_H); const bf16* W = (const bf16*)(C.ws + WS_WDN);
                for (int sI = gw; sI < NS; sI += NGW) { const unsigned hh = dbg_hash(sI * 2 + 1); const int m = hh % M, n = (hh >> 14) % D;
                    dbg_max(C, dbg_rel(dbg_dot(C, H + (size_t)m * FF, W + (size_t)n * FF, FF), bf2f(XN[(size_t)m * D + n]))); } }
            if ((DBG_CHECK & 8) && k == 5) { const bf16* W = (const bf16*)(C.ws + WS_WIN); const bf16* PAp = (const bf16*)(C.ws + WS_PA); const bf16* PLp = (const bf16*)(C.ws + WS_PL);
                for (int sI = gw; sI < NS; sI += NGW) { const unsigned hh = dbg_hash(sI * 2 + 1); const int m = hh % M, n = (hh >> 14) % NAL;
                    const float got = n < WSH ? bf2f(PAp[(size_t)m * WSH + n]) : bf2f(PLp[(size_t)m * 1024 + n - WSH]);
                    dbg_max(C, dbg_rel(dbg_dot(C, XN + (size_t)m * D, W + (size_t)n * D, D), got)); } }
            if ((DBG_CHECK & 16) && k == 9) { const bf16* W = (const bf16*)(C.ws + WS_WIN) + (size_t)NAL * D; const bf16* Yp = (const bf16*)(C.ws + WS_Y);
                const bf16* OAp = (const bf16*)(C.ws + WS_OA); const bf16* OBp = (const bf16*)(C.ws + WS_OB); const bf16* PAT = (const bf16*)(C.ws + WS_PAT); const bf16* PBT = (const bf16*)(C.ws + WS_PBT);
                for (int sI = gw; sI < NS; sI += NGW) { const unsigned hh = dbg_hash(sI * 2 + 1); const int m = hh % M, n = (hh >> 14) % D;
                    const float gr = sigm(dbg_dot(C, XN + (size_t)m * D, W + (size_t)n * D, D)), gl = sigm(dbg_dot(C, XN + (size_t)m * D, W + (size_t)(D + n) * D, D));
                    const float ya = dbg_dot(C, OAp + (size_t)m * RW, PAT + (size_t)n * RW, RW), yb = dbg_dot(C, OBp + (size_t)m * LW, PBT + (size_t)n * LW, LW);
                    const bf16* Gp = (const bf16*)(C.ws + WS_G);
                    if (DBG_SUB == 0) dbg_max(C, dbg_rel(gr * ya + gl * yb, bf2f(Yp[(size_t)m * D + n])));
                    if (DBG_SUB == 1) dbg_max(C, dbg_rel(gr, bf2f(Gp[(size_t)m * NGT + n])));
                    if (DBG_SUB == 2) dbg_max(C, dbg_rel(gl, bf2f(Gp[(size_t)m * NGT + D + n])));
                    if (DBG_SUB == 3) dbg_max(C, dbg_rel(bf2f(Gp[(size_t)m * NGT + n]) * ya + bf2f(Gp[(size_t)m * NGT + D + n]) * yb, bf2f(Yp[(size_t)m * D + n]))); } }
            if ((DBG_CHECK & 32) && k == 10) { const bf16* W = (const bf16*)(C.ws + WS_WOT); const bf16* Yp = (const bf16*)(C.ws + WS_Y);
                for (int sI = gw; sI < NS; sI += NGW) { const unsigned hh = dbg_hash(sI * 2 + 1); const int m = hh % M, n = (hh >> 14) % D;
                    dbg_max(C, dbg_rel(dbg_dot(C, Yp + (size_t)m * D, W + (size_t)n * D, D), bf2f(XN[(size_t)m * D + n]))); } }
            VM_WAIT(); __syncthreads();
        }
        if (dbg_only) continue;
#endif
#if DBG_NAIVE
        if (!dbg_only && ((DBG_NLAYERS >> layer) & 1)) { const size_t gt_ = (size_t)blockIdx.x * 512 + C.tid, NTH = (size_t)GRID * 512; bool done_ = false;
            if ((DBG_NAIVE & 16) && (k == 1 || k == 11)) { bf16* H = (bf16*)(C.ws + WS_H); const bf16* W = (const bf16*)(C.ws + WS_WUP);
                for (size_t i = gt_; i < (size_t)M * FF; i += NTH) { const int m = (int)(i / FF), j = (int)(i % FF); const int rg = (j / 128) * 256 + j % 128;
                    const float gt = naive_dot(XN + (size_t)m * D, W + (size_t)rg * D, D), up = naive_dot(XN + (size_t)m * D, W + (size_t)(rg + 128) * D, D); H[i] = (bf16)f2bf(gt * sigm(gt) * up); } done_ = true; }
            if ((DBG_NAIVE & 1) && (k == 2 || k == 12)) { const bf16* H = (const bf16*)(C.ws + WS_H); const bf16* W = (const bf16*)(C.ws + WS_WDN);
                for (size_t i = gt_; i < (size_t)M * D; i += NTH) { const int m = (int)(i / D), n = (int)(i % D); XN[i] = (bf16)f2bf(naive_dot(H + (size_t)m * FF, W + (size_t)n * FF, FF)); } done_ = true; }
            if ((DBG_NAIVE & 2) && k == 4) { const bf16* W = (const bf16*)(C.ws + WS_WIN); bf16* PAp = (bf16*)(C.ws + WS_PA); bf16* PLp = (bf16*)(C.ws + WS_PL);
                for (size_t i = gt_; i < (size_t)M * NAL; i += NTH) { const int m = (int)(i / NAL), n = (int)(i % NAL); const unsigned v = f2bf(naive_dot(XN + (size_t)m * D, W + (size_t)n * D, D));
                    if (n < WSH) PAp[(size_t)m * WSH + n] = (bf16)v; else PLp[(size_t)m * 1024 + n - WSH] = (bf16)v; } done_ = true; }
            if ((DBG_NAIVE & 4) && k == 8) { const bf16* W = (const bf16*)(C.ws + WS_WIN) + (size_t)NAL * D; bf16* Yp = (bf16*)(C.ws + WS_Y);
                const bf16* OAp = (const bf16*)(C.ws + WS_OA); const bf16* OBp = (const bf16*)(C.ws + WS_OB); const bf16* PAT = (const bf16*)(C.ws + WS_PAT); const bf16* PBT = (const bf16*)(C.ws + WS_PBT);
                for (size_t i = gt_; i < (size_t)M * D; i += NTH) { const int m = (int)(i / D), n = (int)(i % D);
                    const float gr = sigm(naive_dot(XN + (size_t)m * D, W + (size_t)n * D, D)), gl = sigm(naive_dot(XN + (size_t)m * D, W + (size_t)(D + n) * D, D));
                    Yp[i] = (bf16)f2bf(gr * naive_dot(OAp + (size_t)m * RW, PAT + (size_t)n * RW, RW) + gl * naive_dot(OBp + (size_t)m * LW, PBT + (size_t)n * LW, LW)); } done_ = true; }
            if ((DBG_NAIVE & 8) && k == 9) { const bf16* W = (const bf16*)(C.ws + WS_WOT); const bf16* Yp = (const bf16*)(C.ws + WS_Y);
                for (size_t i = gt_; i < (size_t)M * D; i += NTH) { const int m = (int)(i / D), n = (int)(i % D); XN[i] = (bf16)f2bf(naive_dot(Yp + (size_t)m * D, W + (size_t)n * D, D)); } done_ = true; }
            if (done_) continue;
        }
#endif
        if (k == 0 && PHM(0)) {
#if DBG_CHECK || DBG_WCHECK
            if (layer == 0 && blockIdx.x == 0 && C.tid == 0) *DBGW(C) = 0u;
#endif
            if (layer == 0) { conv_ffn(C, 0, 0, gw, NGW); conv_mix(C, 0, gw, NGW); norm_phase(C, INP(0), nullptr, nullptr, 0.f, INP(1), XN); }
        } else if ((k == 1 || k == 11) && PHM(1)) {
            pg8::Gemm gm{XN, (const bf16*)(C.ws + WS_WUP), M, NUP, D}; pg8::StaticOrder S; S.init(M, NUP, C.G, bxp);
            pg8::EpiSwiglu E{(bf16*)(C.ws + WS_H), FF};
            pg8::gemm_phase<pg8::EpiSwiglu, pg8::StaticOrder, true, MK_SP2>(C.lds, gm, S, E);
        } else if ((k == 2 || k == 12) && PHM(2)) {
            pg8::Gemm gm{(const bf16*)(C.ws + WS_H), (const bf16*)(C.ws + WS_WDN), M, D, FF}; pg8::StaticOrder S; S.init(M, D, C.G, bxp);
            pg8::EpiMap<0> E{XN, D, 1 << 20, XN, D};
            pg8::gemm_phase<pg8::EpiMap<0>, pg8::StaticOrder, true, MK_SP2>(C.lds, gm, S, E);
        } else if ((k == 3 || k == 10 || k == 13) && PHM(3)) {
            const int gi = (k == 3) ? 1 : (k == 10 ? 3 : 5); const float* ng = INP(1) + (size_t)layer * 6 * D;
            const float* gpre = (k == 13) ? (layer + 1 < 2 ? INP(1) + (size_t)(layer + 1) * 6 * D : nullptr) : ng + (gi + 1) * D;
            norm_phase(C, C.out, XN, ng + gi * D, (k == 10) ? 1.0f : 0.5f, gpre, XN);
            if (k == 13 && layer == 0) { conv_ffn(C, 1, 0, gw, NGW); conv_mix(C, 1, gw, NGW); }
        } else if (k == 4 && PHM(4)) {
            pg8::Gemm gm{XN, (const bf16*)(C.ws + WS_WIN), M, NAL, D}; pg8::StaticOrder S; S.init(M, NAL, C.G, bxp);
            pg8::EpiMap<0> E{(bf16*)(C.ws + WS_PA), WSH, WSH / 256, (bf16*)(C.ws + WS_PL), 1024};
            pg8::gemm_phase<pg8::EpiMap<0>, pg8::StaticOrder, true, MK_SP2>(C.lds, gm, S, E);
        } else if (k == 5 && PHM(5)) {
            prepA_phase(C, layer);
        } else if (k == 6 && PHM(6)) {
            if (C.vcu < 64) { if (C.wave == 0) stageB_wave(C, C.vcu >> 2, C.vcu & 3); }
            else { const int hw = (C.vcu - 64) * NWAVES + C.wave, NHW = (C.G - 64) * NWAVES;
                for (int it = hw; it < NCHUNK * 8; it += NHW) lru_tile_wave(C, layer, it);
                conv_ffn(C, layer, 1, hw, NHW); }
        } else if (k == 7 && PHM(7)) {
            for (int it = gw; it < NCHUNK * NH; it += NGW) stageC_wave(C, layer, it);
            for (int it = gw; it < NCHUNK * 8; it += NGW) lru_carry_wave(C, layer, it);
        } else if (k == 8 && PHM(8)) {
            pg8::StaticOrder S; S.init(M, D, C.G, bxp); pg8::Unit base;
            for (int i = 0; S.next(i, base); ++i) {
                { pg8::Gemm gm{XN, (const bf16*)(C.ws + WS_WIN) + (size_t)NAL * D, M, NGT, D}; pg8::PairOrder PO{base};
                  pg8::EpiMap<1> E{(bf16*)(C.ws + WS_G), NGT, 1 << 20, (bf16*)(C.ws + WS_G), NGT};
                  pg8::gemm_phase<pg8::EpiMap<1>, pg8::PairOrder, true, MK_SP2>(C.lds, gm, PO, E); }
                { pg8::Gemm gm{(const bf16*)(C.ws + WS_OA), (const bf16*)(C.ws + WS_PAT), M, D, RW}; pg8::OneUnit OU{base};
                  pg8::EpiGateMerge<0> E{(bf16*)(C.ws + WS_Y), D, (const bf16*)(C.ws + WS_G), NGT, 0};
                  pg8::gemm_phase<pg8::EpiGateMerge<0>, pg8::OneUnit, true, MK_SP2>(C.lds, gm, OU, E); }
                { pg8::Gemm gm{(const bf16*)(C.ws + WS_OB), (const bf16*)(C.ws + WS_PBT), M, D, LW}; pg8::OneUnit OU{base};
                  pg8::EpiGateMerge<1> E{(bf16*)(C.ws + WS_Y), D, (const bf16*)(C.ws + WS_G), NGT, D};
                  pg8::gemm_phase<pg8::EpiGateMerge<1>, pg8::OneUnit, true, MK_SP2>(C.lds, gm, OU, E); }
            }
        } else if (k == 9 && PHM(9)) {
            pg8::Gemm gm{(const bf16*)(C.ws + WS_Y), (const bf16*)(C.ws + WS_WOT), M, D, D}; pg8::StaticOrder S; S.init(M, D, C.G, bxp);
            pg8::EpiMap<0> E{XN, D, 1 << 20, XN, D};
            pg8::gemm_phase<pg8::EpiMap<0>, pg8::StaticOrder, true, MK_SP2>(C.lds, gm, S, E);
        }
        if (p + 1 < hi) xcd_barrier(bar);
    }
}

#ifndef MK_ONE_LAUNCH
#define MK_ONE_LAUNCH 1
#endif
extern "C" void kernel_launch(void* const* d_in, const int* in_sizes, int n_in, void* d_out, int out_size, void* d_ws, size_t ws_size, hipStream_t stream) {
    static int grid = 0;
    if (grid == 0) {
        if (n_in != 31 || in_sizes[0] != M * D || out_size != M * D || ws_size < WS_END) { fprintf(stderr, "kernel_launch: unexpected problem (n_in %d, in0 %d, out %d, ws %zu); nothing launched\n", n_in, n_in > 0 ? in_sizes[0] : -1, out_size, ws_size); grid = -1; return; }
        int dev = 0, cus = 0;
        if (hipGetDevice(&dev) != hipSuccess || hipDeviceGetAttribute(&cus, hipDeviceAttributeMultiprocessorCount, dev) != hipSuccess) { grid = -1; return; }
        if (hipFuncSetAttribute((const void*)hybrid_fwd, hipFuncAttributeMaxDynamicSharedMemorySize, LDS_BYTES) != hipSuccess) { fprintf(stderr, "kernel_launch: hipFuncSetAttribute failed\n"); grid = -1; return; }
        (void)hipGetLastError();
        if (cus != GRID) fprintf(stderr, "kernel_launch: built for %d CUs, device has %d\n", GRID, cus);
        grid = GRID;
    }
    if (grid < 0) return;
    (void)hipMemsetAsync((char*)d_ws + WS_CTL, 0, CTL_ZERO_BYTES, stream);
    Args a{};
    for (int i = 0; i < 31; ++i) a.in[i] = (const float*)d_in[i];
    a.out = (float*)d_out; a.ws = (unsigned char*)d_ws;
#if MK_ONE_LAUNCH
    a.ph_lo = 0; a.ph_hi = N_PHASES;
    hipLaunchKernelGGL(hybrid_fwd, dim3(grid), dim3(NWAVES * 64), LDS_BYTES, stream, a);
#else
    for (int p = 0; p < DBG_LAST_PHASE; ++p) {
        if (p == PH_PER_LAYER) continue;
#if DBG_CHECK
        a.ph_lo = 100 + p; a.ph_hi = 101 + p;
        hipLaunchKernelGGL(hybrid_fwd, dim3(grid), dim3(NWAVES * 64), LDS_BYTES, stream, a);
#endif
#if DBG_SPLIT8
        if (p % PH_PER_LAYER == 8) { for (int q = 170; q < 173; ++q) { a.ph_lo = q; a.ph_hi = q + 1; hipLaunchKernelGGL(hybrid_fwd, dim3(grid), dim3(NWAVES * 64), LDS_BYTES, stream, a); } continue; }
#endif
        a.ph_lo = p; a.ph_hi = p + 1;
        hipLaunchKernelGGL(hybrid_fwd, dim3(grid), dim3(NWAVES * 64), LDS_BYTES, stream, a);
#if DBG_WCHECK
        if (p == 0) { a.ph_lo = 160; a.ph_hi = 161; hipLaunchKernelGGL(hybrid_fwd, dim3(grid), dim3(NWAVES * 64), LDS_BYTES, stream, a); }
#endif
#if DBG_SEQ
        if (p == DBG_LAYER * PH_PER_LAYER + 5 && (DBG_SEQ & 1)) { a.ph_lo = 150; a.ph_hi = 151; hipLaunchKernelGGL(hybrid_fwd, dim3(grid), dim3(NWAVES * 64), LDS_BYTES, stream, a); }
        if (p == DBG_LAYER * PH_PER_LAYER + 7 && (DBG_SEQ & 1)) { a.ph_lo = 152; a.ph_hi = 153; hipLaunchKernelGGL(hybrid_fwd, dim3(grid), dim3(NWAVES * 64), LDS_BYTES, stream, a); }
        if (p == DBG_LAYER * PH_PER_LAYER + 7 && (DBG_SEQ & 2)) { a.ph_lo = 151; a.ph_hi = 152; hipLaunchKernelGGL(hybrid_fwd, dim3(grid), dim3(NWAVES * 64), LDS_BYTES, stream, a); }
#endif
    }
#if DBG_LAST_PHASE < 28
    a.ph_lo = 200; a.ph_hi = 201;
    hipLaunchKernelGGL(hybrid_fwd, dim3(grid), dim3(NWAVES * 64), LDS_BYTES, stream, a);
#endif
#endif
}
```

```cpp
#include <hip/hip_runtime.h>
#include <cstdio>
#include <cstdint>
namespace pg8 {
#define PG8_LAS __attribute__((address_space(3)))
typedef unsigned short bf16_t;
typedef short bf16x8 __attribute__((ext_vector_type(8)));
typedef float f32x4 __attribute__((ext_vector_type(4)));
typedef unsigned u32x4 __attribute__((ext_vector_type(4)));
constexpr int BM = 256, BK = 64, HALF = 128, HTB = HALF * BK * 2  , STAGE_BYTES = 8 * HTB, NXCD = 8, WGM = 8;

__host__ __device__ __forceinline__ int lds_byte(int r, int c) { const int st = (r >> 4) * 2 + (c >> 5), rr = r & 15, cc = c & 31, ob = rr * 64 + cc * 2; return st * 1024 + (ob ^ (((ob >> 9) & 1) << 5)); }
__host__ __device__ __forceinline__ void stage_rc(int b, int& R, int& C) { const int st = b / 1024, sb = b % 1024, swz = sb ^ (((sb >> 9) & 1) << 5); R = (st >> 1) * 16 + swz / 64; C = (st & 1) * 32 + (swz % 64) / 2; }
__host__ __device__ __forceinline__ int perm32(int rho) { const int n = rho >> 4, i = rho & 15; return 8 * (i >> 2) + 4 * n + (i & 3); }

__host__ __device__ __forceinline__ int invperm32(int w) { return 16 * ((w >> 2) & 1) + 4 * (w >> 3) + (w & 3); }
__host__ __device__ __forceinline__ size_t img_byte(int r, int k, int K) { return ((size_t)(r >> 8) * (K >> 6) + (k >> 6)) * 32768 + (size_t)(((r >> 7) & 1) * 16384 + lds_byte(r & 127, k & 63)); }
__host__ __device__ __forceinline__ size_t img_byte_w(int n, int k, int K) { return img_byte((n & ~31) + invperm32(n & 31), k, K); }
struct Unit { int pm, pn; };
struct Gemm { const bf16_t* A; const bf16_t* Bt; int M, N, K; };

struct StaticOrder {
    int nM, nN, nwg, G, c;
    __host__ __device__ void init(int M, int N, int G_, int c_) { nM = M / BM; nN = N / BM; nwg = nM * nN; G = G_; c = c_; }
    __host__ __device__ bool next(int i, Unit& u) const {
        const long L = (long)i * G + c; if (L >= nwg) return false;
        int wgid = (int)L; { const int q = nwg / NXCD, r = nwg % NXCD, xcd = wgid % NXCD, off = wgid / NXCD; wgid = (xcd < r ? xcd * (q + 1) : r * (q + 1) + (xcd - r) * q) + off; }
        const int nig = WGM * nN, gid = wgid / nig, fm = gid * WGM, gsz = (nM - fm) < WGM ? (nM - fm) : WGM;
        u.pm = fm + ((wgid % nig) % gsz); u.pn = (wgid % nig) / gsz; return true;
    }
    __device__ __forceinline__ void a_ready(const Unit&) const {}
    __device__ __forceinline__ void done(const Unit&) const {}
};

__device__ __forceinline__ unsigned cvt_pk_bf16(float lo, float hi) { unsigned r; asm volatile("v_cvt_pk_bf16_f32 %0, %1, %2" : "=v"(r) : "v"(lo), "v"(hi)); return r; }
typedef float f32x2 __attribute__((ext_vector_type(2)));
__device__ __forceinline__ f32x2 gelu_pk(f32x2 v) {
    const f32x2 av = __builtin_elementwise_abs(v), d = av * 0.2316418882f + 1.0f;
    f32x2 t; t.x = __builtin_amdgcn_rcpf(d.x); t.y = __builtin_amdgcn_rcpf(d.y);
    f32x2 q = t * 0.5307027145f + (-0.7265760135f); q = q * t + 0.7107068705f; q = q * t + (-0.142248368f); q = q * t + 0.127414796f; q = q * t;
    const f32x2 s = (v * v) * (-0.72134752044f);
    f32x2 e; e.x = __builtin_amdgcn_exp2f(s.x); e.y = __builtin_amdgcn_exp2f(s.y);
    const f32x2 m = v * (q * e), r = v - m;
    f32x2 o; o.x = v.x < 0.f ? m.x : r.x; o.y = v.y < 0.f ? m.y : r.y; return o;
}

template <int ACT  > struct EpiBf16 {
    static constexpr bool PERM = true, AFTER_DRAIN = false; static_assert(ACT == 0 || ACT == 1, "EpiBf16: ACT is 0 (none) or 1 (gelu_pk)");
    bf16_t* O; int ldc; const float* bias; int split_cols; size_t split_stride; float scale0;
    __device__ __forceinline__ void operator()(const f32x4 (&acc)[2][2][4][2], const Unit& u, int wr, int wc, int fr, int fq) const {
        const int row0 = u.pm * BM + wr * 64 + fr; int colt = u.pn * BM; bf16_t* base = O;
        float sc = 1.f; if (split_cols) { const int t = colt / split_cols; base += (size_t)t * split_stride; colt -= t * split_cols; if (t == 0) sc = scale0; }
        const int col0 = colt + wc * 32 + 8 * fq, bcol0 = u.pn * BM + wc * 32 + 8 * fq;
        f32x4 bv[2][2];
#pragma unroll
        for (int bj = 0; bj < 2; ++bj)
#pragma unroll
            for (int n = 0; n < 2; ++n) bv[bj][n] = bias ? *(const f32x4*)(bias + bcol0 + bj * HALF + 4 * n) : (f32x4){0.f, 0.f, 0.f, 0.f};
#pragma unroll
        for (int ai = 0; ai < 2; ++ai)
#pragma unroll
            for (int m = 0; m < 4; ++m) { bf16_t* rowp = base + (size_t)(row0 + ai * HALF + m * 16) * ldc + col0;
#pragma unroll
                for (int bj = 0; bj < 2; ++bj) { f32x4 v0 = acc[ai][bj][m][0] + bv[bj][0], v1 = acc[ai][bj][m][1] + bv[bj][1];
                    if (ACT == 1) { f32x2 a = gelu_pk((f32x2){v0[0], v0[1]}), b = gelu_pk((f32x2){v0[2], v0[3]}), c = gelu_pk((f32x2){v1[0], v1[1]}), d = gelu_pk((f32x2){v1[2], v1[3]});
                        v0 = (f32x4){a.x, a.y, b.x, b.y}; v1 = (f32x4){c.x, c.y, d.x, d.y}; }
                    v0 = v0 * sc; v1 = v1 * sc; u32x4 w; w.x = cvt_pk_bf16(v0[0], v0[1]); w.y = cvt_pk_bf16(v0[2], v0[3]); w.z = cvt_pk_bf16(v1[0], v1[1]); w.w = cvt_pk_bf16(v1[2], v1[3]);
                    *(u32x4*)(rowp + bj * HALF) = w; } }
    }
};

struct PanelStats {
    unsigned* xbuf;
    unsigned* cnt;
    unsigned* tmo;
    int ntn; float eps;
    unsigned code;
    __device__ __forceinline__ bool run(const f32x4 (&v)[2][2][4][2], const Unit& u, int wr, int wc, int fr, int fq, PG8_LAS unsigned char* lds, int wid, int lane) const {
        typedef float f32x2v __attribute__((ext_vector_type(2)));
        PG8_LAS f32x2v* P = (PG8_LAS f32x2v*)lds;
        PG8_LAS f32x2v* S = (PG8_LAS f32x2v*)(lds + 8192);
        PG8_LAS unsigned* flag = (PG8_LAS unsigned*)(lds + 8192 + 2048);
#pragma unroll
        for (int ai = 0; ai < 2; ++ai)
#pragma unroll
            for (int m = 0; m < 4; ++m) {
                float s = 0.f;
#pragma unroll
                for (int bj = 0; bj < 2; ++bj)
#pragma unroll
                    for (int n = 0; n < 2; ++n) { const f32x4 x = v[ai][bj][m][n]; s += (x[0] + x[1]) + (x[2] + x[3]); }
                s += __shfl_xor(s, 16); s += __shfl_xor(s, 32);
                const float mw = s * (1.0f / 64.0f); float q = 0.f;
#pragma unroll
                for (int bj = 0; bj < 2; ++bj)
#pragma unroll
                    for (int n = 0; n < 2; ++n) { const f32x4 d = v[ai][bj][m][n] - mw; q += (d[0] * d[0] + d[1] * d[1]) + (d[2] * d[2] + d[3] * d[3]); }
                q += __shfl_xor(q, 16); q += __shfl_xor(q, 32);
                if (fq == 0) P[(ai * HALF + wr * 64 + m * 16 + fr) * 4 + wc] = (f32x2v){mw, q};
            }
        asm volatile("s_waitcnt lgkmcnt(0)" ::: "memory"); __builtin_amdgcn_s_barrier(); asm volatile("" ::: "memory");
#if defined(BROKEN_EXCHANGE_NO_WAIT)
#warning BROKEN CONTROL BUILD: the row-statistics exchange does not wait; results are wrong by design
        if (blockIdx.x >= 64) { const long long t0_ = clock64(); while (clock64() - t0_ < 60000) __builtin_amdgcn_s_sleep(8); }
#endif
        const int row = wid * 32 + (lane & 31);
        if (lane < 32) {
            const f32x2v a = P[row * 4 + 0], b = P[row * 4 + 1], c = P[row * 4 + 2], d = P[row * 4 + 3];
            const float mt = (a.x + b.x + c.x + d.x) * 0.25f;
            const float da = a.x - mt, db = b.x - mt, dc = c.x - mt, dd = d.x - mt;
            const float m2 = (a.y + b.y) + (c.y + d.y) + 64.0f * ((da * da + db * db) + (dc * dc + dd * dd));
            unsigned long long* slot = (unsigned long long*)xbuf + ((size_t)(u.pm * BM + row) * 4 + u.pn);
            __hip_atomic_store(slot, ((unsigned long long)__float_as_uint(m2) << 32) | __float_as_uint(mt), __ATOMIC_RELAXED, __HIP_MEMORY_SCOPE_AGENT);
        }
        asm volatile("s_waitcnt vmcnt(0)" ::: "memory");
        if (lane == 0) __hip_atomic_fetch_add(cnt + 64 * u.pm, 1u, __ATOMIC_RELAXED, __HIP_MEMORY_SCOPE_AGENT);
        if (wid == 0) {
            bool dead = false; const unsigned long long t0 = __builtin_amdgcn_s_memrealtime(); const unsigned want = 8u * (unsigned)ntn;
            for (;;) {
#if defined(BROKEN_EXCHANGE_NO_WAIT)
                break;
#endif
                if ((unsigned)__builtin_amdgcn_readfirstlane(__hip_atomic_load(cnt + 64 * u.pm, __ATOMIC_RELAXED, __HIP_MEMORY_SCOPE_AGENT)) >= want) break;
                if (__builtin_amdgcn_s_memrealtime() - t0 > 2000000ull) {
                    if (lane == 0) { unsigned expect = 0u; __hip_atomic_compare_exchange_strong(tmo + 1, &expect, code | (unsigned)(u.pm & 0xff), __ATOMIC_RELAXED, __ATOMIC_RELAXED, __HIP_MEMORY_SCOPE_AGENT);
                                     __hip_atomic_store(tmo, 1u, __ATOMIC_RELAXED, __HIP_MEMORY_SCOPE_AGENT); }
                    dead = true; break; }
                __builtin_amdgcn_s_sleep(2);
            }
            __builtin_amdgcn_fence(__ATOMIC_ACQUIRE, "agent");
            if (lane == 0) flag[0] = dead ? 1u : 0u;
        }
        asm volatile("s_waitcnt vmcnt(0) lgkmcnt(0)" ::: "memory"); __builtin_amdgcn_s_barrier(); asm volatile("" ::: "memory");
        const bool bad = flag[0] != 0u;
        if (lane < 32) {
            const unsigned long long* slot = (const unsigned long long*)xbuf + (size_t)(u.pm * BM + row) * 4; float mt[4], m2[4]; float ms = 0.f;
#pragma unroll
            for (int t = 0; t < 4; ++t) { if (t < ntn) { const unsigned long long w = __hip_atomic_load(slot + t, __ATOMIC_RELAXED, __HIP_MEMORY_SCOPE_AGENT); mt[t] = __uint_as_float((unsigned)w); m2[t] = __uint_as_float((unsigned)(w >> 32)); } else { mt[t] = 0.f; m2[t] = 0.f; } ms += mt[t]; }
            const float mean = ms / (float)ntn; float q = 0.f;
#pragma unroll
            for (int t = 0; t < 4; ++t) if (t < ntn) { const float dm = mt[t] - mean; q += m2[t] + 256.0f * dm * dm; }
            S[row] = (f32x2v){mean, 1.0f / sqrtf(q / (256.0f * (float)ntn) + eps)};
        }
        asm volatile("s_waitcnt lgkmcnt(0)" ::: "memory"); __builtin_amdgcn_s_barrier(); asm volatile("" ::: "memory");
        return bad;
    }
};
struct EpiLnRes {
    static constexpr bool PERM = false, AFTER_DRAIN = true;
    const float* base; float* out; int ldc; const float* bias; PanelStats st; unsigned poison;
    __device__ __forceinline__ void fused(f32x4 (&acc)[2][2][4][2], const Unit& u, int wr, int wc, int fr, int fq, PG8_LAS unsigned char* lds, int wid, int lane) const {
        typedef float f32x2v __attribute__((ext_vector_type(2)));
        const PG8_LAS f32x2v* S = (const PG8_LAS f32x2v*)(lds + 8192);
        const int col0 = u.pn * BM + wc * 32 + 4 * fq;
#pragma unroll
        for (int bj = 0; bj < 2; ++bj)
#pragma unroll
            for (int n = 0; n < 2; ++n) { const f32x4 bv = bias ? *(const f32x4*)(bias + col0 + bj * HALF + n * 16) : (f32x4){0.f, 0.f, 0.f, 0.f};
#pragma unroll
                for (int ai = 0; ai < 2; ++ai)
#pragma unroll
                    for (int m = 0; m < 4; ++m) acc[ai][bj][m][n] += bv; }
        f32x4 pre[4][2][2];
#pragma unroll
        for (int m = 0; m < 4; ++m) { const size_t off = (size_t)(u.pm * BM + wr * 64 + m * 16 + fr) * ldc + col0;
#pragma unroll
            for (int bj = 0; bj < 2; ++bj)
#pragma unroll
                for (int n = 0; n < 2; ++n) pre[m][bj][n] = *(const f32x4*)(base + off + bj * HALF + n * 16); }
        const bool bad = st.run(acc, u, wr, wc, fr, fq, lds, wid, lane) || poison != 0u;
        const float qnan = __builtin_nanf("");
#pragma unroll
        for (int ai = 0; ai < 2; ++ai)
#pragma unroll
            for (int m = 0; m < 4; ++m) { const int r = ai * HALF + wr * 64 + m * 16 + fr; const f32x2v sr = S[r]; const size_t off = (size_t)(u.pm * BM + r) * ldc + col0;
#pragma unroll
                for (int bj = 0; bj < 2; ++bj)
#pragma unroll
                    for (int n = 0; n < 2; ++n) { const f32x4 bs = ai == 0 ? pre[m][bj][n] : *(const f32x4*)(base + off + bj * HALF + n * 16); f32x4 o = bs + (acc[ai][bj][m][n] - sr.x) * sr.y;
                        if (bad) o = (f32x4){qnan, qnan, qnan, qnan}; *(f32x4*)(out + off + bj * HALF + n * 16) = o; }
                if (m & 1) asm volatile("" ::: "memory"); }
    }
};
struct EpiLnResLn {
    static constexpr bool PERM = false, AFTER_DRAIN = true;
    const float* base; float* out; bf16_t* xn; int ldc; const float* bias; PanelStats st1, st2; unsigned poison;
    __device__ __forceinline__ void fused(f32x4 (&acc)[2][2][4][2], const Unit& u, int wr, int wc, int fr, int fq, PG8_LAS unsigned char* lds, int wid, int lane) const {
        typedef float f32x2v __attribute__((ext_vector_type(2))); typedef unsigned u32x2v __attribute__((ext_vector_type(2)));
        const PG8_LAS f32x2v* S = (const PG8_LAS f32x2v*)(lds + 8192);
        const int col0 = u.pn * BM + wc * 32 + 4 * fq;
#pragma unroll
        for (int bj = 0; bj < 2; ++bj)
#pragma unroll
            for (int n = 0; n < 2; ++n) { const f32x4 bv = bias ? *(const f32x4*)(bias + col0 + bj * HALF + n * 16) : (f32x4){0.f, 0.f, 0.f, 0.f};
#pragma unroll
                for (int ai = 0; ai < 2; ++ai)
#pragma unroll
                    for (int m = 0; m < 4; ++m) acc[ai][bj][m][n] += bv; }
        bool bad = st1.run(acc, u, wr, wc, fr, fq, lds, wid, lane) || poison != 0u;
        const float qnan = __builtin_nanf("");
#pragma unroll
        for (int ai = 0; ai < 2; ++ai)
#pragma unroll
            for (int m = 0; m < 4; ++m) { const int r = ai * HALF + wr * 64 + m * 16 + fr; const f32x2v sr = S[r]; const size_t off = (size_t)(u.pm * BM + r) * ldc + col0;
#pragma unroll
                for (int bj = 0; bj < 2; ++bj)
#pragma unroll
                    for (int n = 0; n < 2; ++n) { const f32x4 bs = *(const f32x4*)(base + off + bj * HALF + n * 16); acc[ai][bj][m][n] = bs + (acc[ai][bj][m][n] - sr.x) * sr.y; }
                asm volatile("" : "+v"(acc[ai][0][m][0]), "+v"(acc[ai][0][m][1]), "+v"(acc[ai][1][m][0]), "+v"(acc[ai][1][m][1]));
                if (m & 1) asm volatile("" ::: "memory"); }
        const bool bad1 = bad;
        bad = st2.run(acc, u, wr, wc, fr, fq, lds, wid, lane) || bad;
#pragma unroll
        for (int ai = 0; ai < 2; ++ai)
#pragma unroll
            for (int m = 0; m < 4; ++m) { const int r = ai * HALF + wr * 64 + m * 16 + fr; const f32x2v sr = S[r]; const size_t off = (size_t)(u.pm * BM + r) * ldc + col0;
#pragma unroll
                for (int bj = 0; bj < 2; ++bj)
#pragma unroll
                    for (int n = 0; n < 2; ++n) { const f32x4 x1 = acc[ai][bj][m][n]; *(f32x4*)(out + off + bj * HALF + n * 16) = bad1 ? (f32x4){qnan, qnan, qnan, qnan} : x1;
                        const f32x4 o = (x1 - sr.x) * sr.y; u32x2v w; w.x = cvt_pk_bf16(o[0], o[1]); w.y = cvt_pk_bf16(o[2], o[3]);
                        if (bad) { w.x = 0x7fc07fc0u; w.y = 0x7fc07fc0u; } *(u32x2v*)(xn + off + bj * HALF + n * 16) = w; }
                asm volatile("" ::: "memory"); }
    }
};

template <class Epi, class Sched, bool ALIGN_EPI = false, bool SP2 = false>
__device__ __forceinline__ void gemm_phase(PG8_LAS unsigned char* lds, const Gemm g, const Sched& S, const Epi& E) {
    int tid_l = threadIdx.x; asm volatile("" : "+v"(tid_l));
    const int tid = tid_l, wid = __builtin_amdgcn_readfirstlane(tid >> 6), lane = tid & 63, wr = wid >> 2, wc = wid & 3, fr = lane & 15, fq = lane >> 4;
    const int K = g.K, nt = K / BK;
    unsigned voffA[2], voffB[2];
    static_assert(Epi::PERM, "the weight images are stored with the PERM row order (img_byte_w)");
#pragma unroll
    for (int i = 0; i < 2; ++i) { voffA[i] = (unsigned)(tid * 16 + i * 8192); voffB[i] = voffA[i]; }
    const size_t kstep = (size_t)BM * BK * 2;
    const size_t hstep = (size_t)HALF * BK * 2;
    const size_t tstep = (size_t)BM * K * 2;
    const size_t kstepA = kstep, hstepA = hstep;
    const unsigned ldsw = (unsigned)wid * 1024u;
    const int aoff = lds_byte(wr * 64 + fr, fq * 8), boff = lds_byte(wc * 32 + fr, fq * 8);
#define PG8_SA(b, h) (((b) * 2 + (h)) * HTB)
#define PG8_SB(b, h) ((4 + (b) * 2 + (h)) * HTB)
#define PG8_STAGE(bufoff, gbase, voff) do { _Pragma("unroll") for (int _i = 0; _i < 2; ++_i) \
        __builtin_amdgcn_global_load_lds((const unsigned*)((const char*)(gbase) + (voff)[_i]), (PG8_LAS unsigned*)(lds + (bufoff) + ldsw + _i * 8192), 16, 0, 0); } while (0)
#define PG8_LDA(dst, b, h) do { _Pragma("unroll") for (int m = 0; m < 4; ++m) _Pragma("unroll") for (int k = 0; k < 2; ++k) dst[m][k] = *(const PG8_LAS bf16x8*)(lds + PG8_SA(b, h) + aoff + m * 2048 + k * 1024); } while (0)
#define PG8_LDB(dst, b, h) do { _Pragma("unroll") for (int n = 0; n < 2; ++n) _Pragma("unroll") for (int k = 0; k < 2; ++k) dst[n][k] = *(const PG8_LAS bf16x8*)(lds + PG8_SB(b, h) + boff + n * 2048 + k * 1024); } while (0)
#define PG8_MMA(ai, bj, At, Bt) do { __builtin_amdgcn_s_setprio(1); _Pragma("unroll") for (int m = 0; m < 4; ++m) _Pragma("unroll") for (int n = 0; n < 2; ++n) _Pragma("unroll") for (int k = 0; k < 2; ++k) \
        acc[ai][bj][m][n] = __builtin_amdgcn_mfma_f32_16x16x32_bf16(Bt[n][k], At[m][k], acc[ai][bj][m][n], 0, 0, 0); __builtin_amdgcn_s_setprio(0); } while (0)
#define PG8_WAIT_V(n) asm volatile("s_waitcnt vmcnt(" #n ")" ::: "memory")
#define PG8_WAIT_L(n) asm volatile("s_waitcnt lgkmcnt(" #n ")" ::: "memory")
#define PG8_BAR __builtin_amdgcn_s_barrier()
#define PG8_SCHED __builtin_amdgcn_sched_barrier(0)
    Unit cur, nxt; int ui = 0;
    if (!S.next(0, cur)) return;
    f32x4 acc[2][2][4][2];
#pragma unroll
    for (int a = 0; a < 2; ++a)
#pragma unroll
        for (int b = 0; b < 2; ++b)
#pragma unroll
            for (int m = 0; m < 4; ++m)
#pragma unroll
                for (int n = 0; n < 2; ++n) acc[a][b][m][n] = (f32x4){0.f, 0.f, 0.f, 0.f};
    bf16x8 At[4][2], B0[2][2], B1[2][2];
    const char* cA = (const char*)g.A + (size_t)cur.pm * tstep; const char* cB = (const char*)g.Bt + (size_t)cur.pn * tstep;
    S.a_ready(cur);
    if constexpr (SP2) {
        PG8_STAGE(PG8_SB(0, 0), cB, voffB); PG8_STAGE(PG8_SB(0, 1), cB + hstep, voffB); PG8_STAGE(PG8_SA(0, 0), cA, voffA); PG8_STAGE(PG8_SA(0, 1), cA + hstepA, voffA);
        if (wr == 1) PG8_BAR;
        PG8_WAIT_V(2); PG8_BAR;
        PG8_STAGE(PG8_SB(1, 0), cB + kstep, voffB); PG8_STAGE(PG8_SA(1, 0), cA + kstepA, voffA); PG8_STAGE(PG8_SB(1, 1), cB + hstep + kstep, voffB);
        PG8_WAIT_V(6); PG8_BAR;
    } else {
        PG8_STAGE(PG8_SB(0, 0), cB, voffB); PG8_STAGE(PG8_SA(0, 0), cA, voffA); PG8_STAGE(PG8_SB(0, 1), cB + hstep, voffB); PG8_STAGE(PG8_SA(0, 1), cA + hstepA, voffA);
        if (wr == 1) PG8_BAR;
        PG8_WAIT_V(4); PG8_BAR;
        PG8_STAGE(PG8_SB(1, 0), cB + kstep, voffB); PG8_STAGE(PG8_SA(1, 0), cA + kstepA, voffA); PG8_STAGE(PG8_SB(1, 1), cB + hstep + kstep, voffB);
        PG8_WAIT_V(6); PG8_BAR;
    }
    for (;;) {
        const bool has_next = S.next(ui + 1, nxt);
        const char* nA = has_next ? (const char*)g.A + (size_t)nxt.pm * tstep : cA; const char* nB = has_next ? (const char*)g.Bt + (size_t)nxt.pn * tstep : cB;
        for (int t = 0; t < nt; t += 2) {
            const bool last = (t == nt - 2);
            const char* a1 = cA + (size_t)(t + 1) * kstepA;
            const char* a2 = last ? nA : cA + (size_t)(t + 2) * kstepA; const char* b2 = last ? nB : cB + (size_t)(t + 2) * kstep;
            const char* a3 = a2 + kstepA; const char* b3 = b2 + kstep;
            if (last && has_next) S.a_ready(nxt);
            if constexpr (SP2) {
            PG8_LDB(B0, 0, 0); PG8_LDB(B1, 0, 1); PG8_SCHED; PG8_LDA(At, 0, 0); PG8_STAGE(PG8_SA(1, 1), a1 + hstepA, voffA);
            PG8_WAIT_V(8); PG8_WAIT_L(0); PG8_BAR; PG8_MMA(0, 0, At, B0); PG8_MMA(0, 1, At, B1); PG8_BAR; PG8_SCHED;
            PG8_LDA(At, 0, 1); PG8_STAGE(PG8_SB(0, 0), b2, voffB); PG8_STAGE(PG8_SB(0, 1), b2 + hstep, voffB); PG8_STAGE(PG8_SA(0, 0), a2, voffA);
            PG8_WAIT_V(8); PG8_WAIT_L(0); PG8_BAR; PG8_MMA(1, 0, At, B0); PG8_MMA(1, 1, At, B1); PG8_BAR; PG8_SCHED;
            PG8_LDB(B0, 1, 0); PG8_LDB(B1, 1, 1); PG8_SCHED; PG8_LDA(At, 1, 0); PG8_STAGE(PG8_SA(0, 1), a2 + hstepA, voffA);
            PG8_WAIT_V(8); PG8_WAIT_L(0); PG8_BAR; PG8_MMA(0, 0, At, B0); PG8_MMA(0, 1, At, B1); PG8_BAR; PG8_SCHED;
            PG8_LDA(At, 1, 1); PG8_STAGE(PG8_SB(1, 0), b3, voffB); PG8_STAGE(PG8_SB(1, 1), b3 + hstep, voffB); PG8_STAGE(PG8_SA(1, 0), a3, voffA);
            PG8_WAIT_V(8); PG8_WAIT_L(0); PG8_BAR; PG8_MMA(1, 0, At, B0); PG8_MMA(1, 1, At, B1); PG8_BAR; PG8_SCHED;
            } else {
            PG8_LDB(B0, 0, 0); PG8_SCHED; PG8_LDA(At, 0, 0); PG8_STAGE(PG8_SA(1, 1), a1 + hstepA, voffA);
            PG8_WAIT_L(8); PG8_BAR; PG8_WAIT_L(0); PG8_MMA(0, 0, At, B0); PG8_BAR; PG8_SCHED;
            PG8_LDB(B1, 0, 1); PG8_STAGE(PG8_SB(0, 0), b2, voffB);
            PG8_BAR; PG8_WAIT_L(0); PG8_MMA(0, 1, At, B1); PG8_BAR;
            PG8_LDA(At, 0, 1); PG8_STAGE(PG8_SA(0, 0), a2, voffA);
            PG8_BAR; PG8_WAIT_L(0); PG8_MMA(1, 0, At, B0); PG8_BAR; PG8_SCHED;
            PG8_STAGE(PG8_SB(0, 1), b2 + hstep, voffB);
            PG8_WAIT_V(6); PG8_BAR; PG8_MMA(1, 1, At, B1); PG8_BAR;
            PG8_LDB(B0, 1, 0); PG8_SCHED; PG8_LDA(At, 1, 0); PG8_STAGE(PG8_SA(0, 1), a2 + hstepA, voffA);
            PG8_WAIT_L(8); PG8_BAR; PG8_WAIT_L(0); PG8_MMA(0, 0, At, B0); PG8_BAR; PG8_SCHED;
            PG8_LDB(B1, 1, 1); PG8_STAGE(PG8_SB(1, 0), b3, voffB);
            PG8_BAR; PG8_WAIT_L(0); PG8_MMA(0, 1, At, B1); PG8_BAR;
            PG8_LDA(At, 1, 1); PG8_STAGE(PG8_SA(1, 0), a3, voffA);
            PG8_BAR; PG8_WAIT_L(0); PG8_MMA(1, 0, At, B0); PG8_BAR; PG8_SCHED;
            PG8_STAGE(PG8_SB(1, 1), b3 + hstep, voffB);
            PG8_WAIT_V(6); PG8_BAR; PG8_MMA(1, 1, At, B1); PG8_BAR;
            }
        }
        if constexpr (ALIGN_EPI) { if (wr == 0) PG8_BAR; }
        if constexpr (!Epi::AFTER_DRAIN) { E(acc, cur, wr, wc, fr, fq); S.done(cur); }
        if (!has_next) break;
#pragma unroll
        for (int a = 0; a < 2; ++a)
#pragma unroll
            for (int b = 0; b < 2; ++b)
#pragma unroll
                for (int m = 0; m < 4; ++m)
#pragma unroll
                    for (int n = 0; n < 2; ++n) acc[a][b][m][n] = (f32x4){0.f, 0.f, 0.f, 0.f};
        cur = nxt; cA = nA; cB = nB; ++ui;
        if constexpr (ALIGN_EPI) { if (wr == 1) PG8_BAR; }
    }
    PG8_WAIT_V(0);
    if constexpr (!ALIGN_EPI) { if (wr == 0) PG8_BAR; }
    PG8_BAR;
    if constexpr (Epi::AFTER_DRAIN) { E.fused(acc, cur, wr, wc, fr, fq, lds, wid, lane); S.done(cur); }
#undef PG8_SA
#undef PG8_SB
#undef PG8_STAGE
#undef PG8_LDA
#undef PG8_LDB
#undef PG8_MMA
#undef PG8_WAIT_V
#undef PG8_WAIT_L
#undef PG8_BAR
#undef PG8_SCHED
}
}
namespace pg8 {
__device__ __forceinline__ float sigmoidf_fast(float x) { return __builtin_amdgcn_rcpf(1.0f + __expf(-x)); }
typedef float f32x2_c __attribute__((ext_vector_type(2))); typedef __bf16 bf16x2_c __attribute__((ext_vector_type(2)));
__device__ __forceinline__ unsigned cvt_pk_safe(float lo, float hi) { const f32x2_c v = {lo, hi}; const bf16x2_c b = __builtin_convertvector(v, bf16x2_c); return __builtin_bit_cast(unsigned, b); }
struct EpiSwiglu {
    static constexpr bool PERM = true, AFTER_DRAIN = false;
    bf16_t* O; int ldc;
    __device__ __forceinline__ void operator()(const f32x4 (&acc)[2][2][4][2], const Unit& u, int wr, int wc, int fr, int fq) const {
        const int row0 = u.pm * BM + wr * 64 + fr, col0 = u.pn * HALF + wc * 32 + 8 * fq;
#pragma unroll
        for (int ai = 0; ai < 2; ++ai)
#pragma unroll
            for (int m = 0; m < 4; ++m) { const int rr = wr * 64 + fr + ai * HALF + m * 16;
                bf16_t* rowp = (bf16_t*)((char*)O + img_byte(u.pm * BM + rr, col0, ldc));
                unsigned wv[4];
#pragma unroll
                for (int n = 0; n < 2; ++n)
#pragma unroll
                    for (int e = 0; e < 4; e += 2) { const f32x2_c g = {acc[ai][0][m][n][e], acc[ai][0][m][n][e + 1]}, up = {acc[ai][1][m][n][e], acc[ai][1][m][n][e + 1]};
                        const f32x2_c d = (f32x2_c){__builtin_amdgcn_exp2f(g[0]), __builtin_amdgcn_exp2f(g[1])} + 1.0f;
                        const f32x2_c r = {__builtin_amdgcn_rcpf(d[0]), __builtin_amdgcn_rcpf(d[1])};
                        const f32x2_c o = g * up * r; wv[n * 2 + (e >> 1)] = cvt_pk_safe(o[0], o[1]); }
                u32x4 w; w.x = wv[0]; w.y = wv[1]; w.z = wv[2]; w.w = wv[3];
                *(u32x4*)rowp = w; }
    }
};
template <int ACT> struct EpiMap {
    static constexpr bool PERM = true, AFTER_DRAIN = false;
    bf16_t* O0; int ld0; int t1; bf16_t* O1; int ld1;
    __device__ __forceinline__ void operator()(const f32x4 (&acc)[2][2][4][2], const Unit& u, int wr, int wc, int fr, int fq) const {
        const int row0 = u.pm * BM + wr * 64 + fr;
        bf16_t* base; int ld, colt;
        if (u.pn < t1) { base = O0; ld = ld0; colt = u.pn * BM; } else { base = O1; ld = ld1; colt = (u.pn - t1) * BM; }
        const int col0 = colt + wc * 32 + 8 * fq;
#pragma unroll
        for (int ai = 0; ai < 2; ++ai)
#pragma unroll
            for (int m = 0; m < 4; ++m) { bf16_t* rowp = base + (size_t)(row0 + ai * HALF + m * 16) * ld + col0;
#pragma unroll
                for (int bj = 0; bj < 2; ++bj) { f32x4 v0 = acc[ai][bj][m][0], v1 = acc[ai][bj][m][1];
                    bf16_t* dst = ACT == 1 ? (bf16_t*)((char*)base + img_byte(row0 + ai * HALF + m * 16, col0 + bj * HALF, ld)) : rowp + bj * HALF;
                    if (ACT == 1) {
#pragma unroll
                        for (int e = 0; e < 4; ++e) { v0[e] = __builtin_amdgcn_rcpf(1.0f + __builtin_amdgcn_exp2f(v0[e])); v1[e] = __builtin_amdgcn_rcpf(1.0f + __builtin_amdgcn_exp2f(v1[e])); } }
                    u32x4 w; w.x = cvt_pk_safe(v0[0], v0[1]); w.y = cvt_pk_safe(v0[2], v0[3]); w.z = cvt_pk_safe(v1[0], v1[1]); w.w = cvt_pk_safe(v1[2], v1[3]);
                    *(u32x4*)dst = w; } }
    }
};
__device__ __forceinline__ float bfu_lo(unsigned w) { return __uint_as_float(w << 16); }
__device__ __forceinline__ float bfu_hi(unsigned w) { return __uint_as_float(w & 0xffff0000u); }
struct EpiGateMerge2 {
    static constexpr bool PERM = true, AFTER_DRAIN = false;
    bf16_t* Y; int ldy; const bf16_t* G; int ldg;
    __device__ __forceinline__ void operator()(const f32x4 (&acc)[2][2][4][2], const Unit& u, int wr, int wc, int fr, int fq) const {
        const bool second = u.pm >= 64; const int pm = second ? u.pm - 64 : u.pm, pn = second ? u.pn - 4 : u.pn, goff = second ? 4 * BM : 0;
        const int row0 = pm * BM + wr * 64 + fr, col0 = pn * BM + wc * 32 + 8 * fq;
#pragma unroll
        for (int ai = 0; ai < 2; ++ai) {
            u32x4 gq[4][2], yq[4][2];
#pragma unroll
            for (int m = 0; m < 4; ++m)
#pragma unroll
                for (int bj = 0; bj < 2; ++bj) { const int r = row0 + ai * HALF + m * 16, c = col0 + bj * HALF;
                    gq[m][bj] = *(const u32x4*)((const char*)G + img_byte(r, goff + c, ldg));
                    if (second) yq[m][bj] = *(const u32x4*)((const char*)Y + img_byte(r, c, ldy)); }
#pragma unroll
            for (int m = 0; m < 4; ++m)
#pragma unroll
                for (int bj = 0; bj < 2; ++bj) { const int r = row0 + ai * HALF + m * 16, c = col0 + bj * HALF;
                    const u32x4 gv = gq[m][bj];
                    bf16_t* yp = (bf16_t*)((char*)Y + img_byte(r, c, ldy));
                    const f32x4 a0 = acc[ai][bj][m][0], a1 = acc[ai][bj][m][1];
                    float v[8];
                    v[0] = bfu_lo(gv.x) * a0[0]; v[1] = bfu_hi(gv.x) * a0[1]; v[2] = bfu_lo(gv.y) * a0[2]; v[3] = bfu_hi(gv.y) * a0[3];
                    v[4] = bfu_lo(gv.z) * a1[0]; v[5] = bfu_hi(gv.z) * a1[1]; v[6] = bfu_lo(gv.w) * a1[2]; v[7] = bfu_hi(gv.w) * a1[3];
                    if (second) { const u32x4 yv = yq[m][bj];
                        v[0] += bfu_lo(yv.x); v[1] += bfu_hi(yv.x); v[2] += bfu_lo(yv.y); v[3] += bfu_hi(yv.y);
                        v[4] += bfu_lo(yv.z); v[5] += bfu_hi(yv.z); v[6] += bfu_lo(yv.w); v[7] += bfu_hi(yv.w); }
                    u32x4 w; w.x = cvt_pk_safe(v[0], v[1]); w.y = cvt_pk_safe(v[2], v[3]); w.z = cvt_pk_safe(v[4], v[5]); w.w = cvt_pk_safe(v[6], v[7]);
                    *(u32x4*)yp = w; }
            asm volatile("" ::: "memory");
        }
    }
};
struct XPairOrder { Unit base;
    __device__ __forceinline__ bool next(int i, Unit& u) const { if (i >= 2) return false; u.pm = base.pm + 64 * i; u.pn = base.pn + 4 * i; return true; }
    __device__ __forceinline__ void a_ready(const Unit&) const {}
    __device__ __forceinline__ void done(const Unit&) const {} };
struct PairOrder { Unit base;
    __device__ __forceinline__ bool next(int i, Unit& u) const { if (i >= 2) return false; u.pm = base.pm; u.pn = base.pn + 4 * i; return true; }
    __device__ __forceinline__ void a_ready(const Unit&) const {}
    __device__ __forceinline__ void done(const Unit&) const {} };
}
constexpr int NWAVES = 8, GRID = 256;
constexpr int BATCH = 2, T = 8192, M = BATCH * T, D = 1024, FF = 2816, NUP = 2 * FF, WIN = 4864, WSH = 1792, RW = 512, LW = 512, NH = 8, HD = 64;
constexpr int NAL = 2816;
constexpr int NGT = 2048;
constexpr int NCHUNK = M / 64;
constexpr int NCH_SEQ = T / 64;
constexpr float RMS_EPS = 1e-6f, GN_EPS = 64e-5f;
constexpr int PH_PER_LAYER = 14, N_PHASES = 2 * PH_PER_LAYER;

constexpr size_t MiB = 1u << 20;
constexpr size_t WS_CTL = 0, CW_CNT_OFF = 64 * 1024, CNT_BYTES = 16 * 1024, CTL_ZERO_BYTES = CW_CNT_OFF + 12 * CNT_BYTES;
constexpr size_t WS_WUP = 1 * MiB;
constexpr size_t WS_WDN = WS_WUP + (size_t)NUP * D * 2;
constexpr size_t WS_WIN = 18 * MiB;
constexpr size_t WS_PAT = WS_WIN + (size_t)WIN * D * 2;
constexpr size_t WS_PBT = WS_PAT + (size_t)D * RW * 2;
constexpr size_t WS_WOT = WS_PBT + (size_t)D * LW * 2;
constexpr size_t WS_SMALL = WS_WOT + (size_t)D * D * 2;
constexpr size_t WS_WUT = WS_SMALL;
constexpr size_t WS_AUT = WS_WUT + 512 * 64 * 2;
constexpr size_t WS_GUT = WS_AUT + 512 * 64 * 2;
constexpr size_t WS_VDT = WS_GUT + 512 * 128 * 2;
constexpr size_t WS_VUT = WS_VDT + 32 * 512 * 2;
constexpr size_t WS_LWA = WS_VUT + 512 * 32 * 2;
constexpr size_t WS_LWX = WS_LWA + 8 * 64 * 64 * 2;
constexpr size_t WS_PT = WS_LWX + 8 * 64 * 64 * 2;
constexpr size_t WS_SMALL_END = WS_PT + 512 * 12 * 4;
static_assert(WS_WDN + (size_t)D * FF * 2 <= WS_WIN && WS_SMALL_END <= 32 * MiB, "weight map");
constexpr size_t WS_VF = 32 * MiB;
constexpr size_t WS_XN = 48 * MiB;
constexpr size_t WS_BS = 80 * MiB;
constexpr size_t WS_RSI = 80 * MiB + 768 * 1024;
constexpr size_t WS_AGG = 81 * MiB;
constexpr size_t WS_GG = 82 * MiB;
constexpr size_t WS_LOC = 98 * MiB;
constexpr size_t WS_H = WS_LOC;
constexpr size_t WS_PA = WS_LOC;
constexpr size_t WS_PL = WS_LOC + 56 * MiB;
constexpr size_t WS_SP = WS_LOC + 88 * MiB;
constexpr size_t WS_SQ = WS_SP + 16 * MiB;
constexpr size_t WS_SR = WS_SQ + 16 * MiB;
constexpr size_t WS_SY = WS_SR + 16 * MiB;
constexpr size_t WS_HC = WS_LOC;
constexpr size_t WS_HL = WS_LOC + 16 * MiB;
constexpr size_t WS_AP = WS_LOC + 32 * MiB;
constexpr size_t WS_OA = WS_SP;
constexpr size_t WS_OB = WS_SQ;
constexpr size_t WS_G = WS_LOC;
constexpr size_t WS_Y = WS_SR;
constexpr size_t WS_XS = WS_SY + 16 * MiB, XS_BYTES = 512 * 1024;
constexpr size_t WS_END = WS_XS + 12 * XS_BYTES;
__host__ __device__ constexpr size_t ffn_w_off(int layer, int which) { return (layer == 1 && which == 0) ? WS_SP : WS_WUP; }
static_assert((size_t)NUP * D * 2 + (size_t)D * FF * 2 <= 32 * MiB, "second FFN weight buffer fits in SP | SQ");
static_assert(WS_OB == WS_OA + (size_t)M * RW * 2 && WS_PBT == WS_PAT + (size_t)D * RW * 2, "the merge GEMM pair addresses o_A|o_B and P_A^T|P_B^T as one operand each");
static_assert(WS_END <= 256 * MiB && WS_H + (size_t)M * FF * 2 <= 256 * MiB && WS_G + (size_t)M * NGT * 2 <= WS_SP, "d_ws map");
constexpr float NL2E = -1.4426950408889634f, NLN2 = -0.6931471805599453f;
constexpr int CW_BAR = 1024;

constexpr int SLOT = 8192;
constexpr int LDS_WORK = 18 * SLOT;
constexpr int MISC_OFF = LDS_WORK;
constexpr int TAB_OFF = MISC_OFF + 256;
constexpr int LDS_BYTES = LDS_WORK + 1024;

#define GAS __attribute__((address_space(1)))
#define LAS __attribute__((address_space(3)))
typedef unsigned short bf16;
typedef unsigned v4u __attribute__((ext_vector_type(4)));
typedef unsigned v2u __attribute__((ext_vector_type(2)));
typedef float f32x4 __attribute__((ext_vector_type(4)));
typedef short bf16x8 __attribute__((ext_vector_type(8)));
typedef GAS unsigned gu32;
typedef LAS unsigned char* lptr;
#define RLX_AGENT __ATOMIC_RELAXED, __HIP_MEMORY_SCOPE_AGENT
#define LDS_WAIT() asm volatile("s_waitcnt lgkmcnt(0)" ::: "memory")
#define VM_WAIT() asm volatile("s_waitcnt vmcnt(0)" ::: "memory")
typedef __bf16 bf16x2_p __attribute__((ext_vector_type(2))); typedef float f32x2_p __attribute__((ext_vector_type(2)));
__device__ __forceinline__ unsigned pk2(float lo, float hi) { const f32x2_p v = {lo, hi}; return __builtin_bit_cast(unsigned, __builtin_convertvector(v, bf16x2_p)); }
__device__ __forceinline__ unsigned f2bf(float f) { return pk2(f, 0.f) & 0xffffu; }
__device__ __forceinline__ float bf2f(unsigned h) { return __uint_as_float(h << 16); }
__device__ __forceinline__ float bflo(unsigned w) { return __uint_as_float(w << 16); }
__device__ __forceinline__ float bfhi(unsigned w) { return __uint_as_float(w & 0xffff0000u); }
__device__ __forceinline__ float sigm(float x) { return __builtin_amdgcn_rcpf(1.0f + __expf(-x)); }
__device__ __forceinline__ float tanh_fast(float x) { const float e = __expf(2.0f * x); return 1.0f - 2.0f * __builtin_amdgcn_rcpf(e + 1.0f); }
__device__ __forceinline__ float bperm(float v, int src_lane) { return __int_as_float(__builtin_amdgcn_ds_bpermute(src_lane << 2, __float_as_int(v))); }
#define DPP_ADD(v, ctrl) ((v) + __int_as_float(__builtin_amdgcn_mov_dpp(__float_as_int(v), (ctrl), 0xF, 0xF, true)))
__device__ __forceinline__ float wave_sum(float v, int  ) {
    v = DPP_ADD(v, 0xB1);
    v = DPP_ADD(v, 0x4E);
    v = DPP_ADD(v, 0x141);
    v = DPP_ADD(v, 0x140);
    const int x = __float_as_int(v);
    return (__int_as_float(__builtin_amdgcn_readlane(x, 0)) + __int_as_float(__builtin_amdgcn_readlane(x, 16))) + (__int_as_float(__builtin_amdgcn_readlane(x, 32)) + __int_as_float(__builtin_amdgcn_readlane(x, 48)));
}
__device__ __forceinline__ f32x4 mfma16(bf16x8 a, bf16x8 b, f32x4 c) { return __builtin_amdgcn_mfma_f32_16x16x32_bf16(a, b, c, 0, 0, 0); }

__device__ __forceinline__ int sw_off(int r, int c) { return r * 128 + ((c << 1) ^ ((r & 7) << 4)); }
__device__ __forceinline__ bf16x8 lds_frag(lptr base, int row, int c8) { return *(const LAS bf16x8*)(base + sw_off(row, c8)); }
__device__ __forceinline__ void lds_st16(lptr base, int r, int c, float v) { *(LAS bf16*)(base + sw_off(r, c)) = (bf16)f2bf(v); }
__device__ __forceinline__ float lds_ld16(lptr base, int r, int c) { return bf2f(*(const LAS bf16*)(base + sw_off(r, c))); }
__device__ __forceinline__ void lds_st4(lptr base, int r, int c4, f32x4 v) { v2u w; w.x = pk2(v[0], v[1]); w.y = pk2(v[2], v[3]); *(LAS v2u*)(base + sw_off(r, c4)) = w; }
__device__ __forceinline__ f32x4 lds_ld4(lptr base, int r, int c4) { const v2u w = *(const LAS v2u*)(base + sw_off(r, c4)); return (f32x4){bflo(w.x), bfhi(w.x), bflo(w.y), bfhi(w.y)}; }
__device__ __forceinline__ bf16x8 gl_frag(const bf16* p) { return *(const GAS bf16x8*)p; }
__device__ __forceinline__ f32x4 gl_ld4(const bf16* p) { const v2u w = *(const GAS v2u*)p; return (f32x4){bflo(w.x), bfhi(w.x), bflo(w.y), bfhi(w.y)}; }
__device__ __forceinline__ void gl_st4(bf16* p, f32x4 v) { v2u w; w.x = pk2(v[0], v[1]); w.y = pk2(v[2], v[3]); *(GAS v2u*)p = w; }

template <bool SW>
__device__ __forceinline__ void mma64(f32x4 (&acc)[2], lptr A, lptr B, int mt, int ntb, int lane) {
    const int r16 = lane & 15, g = lane >> 4;
#pragma unroll
    for (int s = 0; s < 2; ++s) {
        const bf16x8 a = lds_frag(A, 16 * mt + r16, 32 * s + 8 * g);
#pragma unroll
        for (int q = 0; q < 2; ++q) {
            const bf16x8 b = lds_frag(B, 16 * (ntb + q) + r16, 32 * s + 8 * g);
            acc[q] = SW ? mfma16(b, a, acc[q]) : mfma16(a, b, acc[q]);
        }
    }
}
__device__ __forceinline__ void mma64_both(f32x4 (&accn)[2], f32x4 (&accs)[2], lptr A, lptr B, int mt, int ntb, int lane) {
    const int r16 = lane & 15, g = lane >> 4;
#pragma unroll
    for (int s = 0; s < 2; ++s) {
        const bf16x8 a = lds_frag(A, 16 * mt + r16, 32 * s + 8 * g);
#pragma unroll
        for (int q = 0; q < 2; ++q) {
            const bf16x8 b = lds_frag(B, 16 * (ntb + q) + r16, 32 * s + 8 * g);
            accn[q] = mfma16(a, b, accn[q]); accs[q] = mfma16(b, a, accs[q]);
        }
    }
}
#define ZERO2(acc) do { acc[0] = (f32x4){0.f, 0.f, 0.f, 0.f}; acc[1] = (f32x4){0.f, 0.f, 0.f, 0.f}; } while (0)
#define LDS_BAR() do { asm volatile("s_waitcnt lgkmcnt(0)" ::: "memory"); __builtin_amdgcn_s_barrier(); asm volatile("" ::: "memory"); } while (0)
#define WG_BAR() do { asm volatile("s_waitcnt vmcnt(0) lgkmcnt(0)" ::: "memory"); __builtin_amdgcn_s_barrier(); asm volatile("" ::: "memory"); } while (0)
namespace pg8 {
constexpr unsigned XS_TAG = 0x5EED0001u;
struct RmsStats {
    unsigned long long* xbuf;
    unsigned* tmo;
    float eps;
    __device__ __forceinline__ void run(const f32x4 (&v)[2][2][4][2], const Unit& u, int wr, int wc, int fr, int fq, PG8_LAS unsigned char* lds, int wid, int lane) const {
        PG8_LAS float* P = (PG8_LAS float*)lds;
        PG8_LAS float* S = (PG8_LAS float*)(lds + 8192);
#pragma unroll
        for (int ai = 0; ai < 2; ++ai)
#pragma unroll
            for (int m = 0; m < 4; ++m) {
                float s = 0.f;
#pragma unroll
                for (int bj = 0; bj < 2; ++bj)
#pragma unroll
                    for (int n = 0; n < 2; ++n) { const f32x4 x = v[ai][bj][m][n]; s += (x[0] * x[0] + x[1] * x[1]) + (x[2] * x[2] + x[3] * x[3]); }
                s += bperm(s, lane ^ 16); s += bperm(s, lane ^ 32);
                if (fq == 0) P[(ai * HALF + wr * 64 + m * 16 + fr) * 4 + wc] = s;
            }
        asm volatile("s_waitcnt lgkmcnt(0)" ::: "memory"); __builtin_amdgcn_s_barrier(); asm volatile("" ::: "memory");
        const int row = wid * 32 + (lane & 31);
        if (lane < 32) {
            const float tot = (P[row * 4 + 0] + P[row * 4 + 1]) + (P[row * 4 + 2] + P[row * 4 + 3]);
            unsigned long long* slot = xbuf + (size_t)(u.pm * BM + row) * 4;
            unsigned tagv = XS_TAG; asm volatile("" : "+v"(tagv));
            __hip_atomic_store(slot + u.pn, ((unsigned long long)tagv << 32) | (unsigned long long)__float_as_uint(tot), __ATOMIC_RELAXED, __HIP_MEMORY_SCOPE_AGENT);
            unsigned long long gq[4] = {0ull, 0ull, 0ull, 0ull}; unsigned sp = 0u;
            for (;;) { bool ok = true;
#pragma unroll
                for (int t = 0; t < 4; ++t) if (t != u.pn) gq[t] = __hip_atomic_load(slot + t, __ATOMIC_RELAXED, __HIP_MEMORY_SCOPE_AGENT);
#pragma unroll
                for (int t = 0; t < 4; ++t) if (t != u.pn) ok = ok && ((unsigned)(gq[t] >> 32) == XS_TAG);
                if (ok) break;
                if (++sp > (1u << 20)) { __hip_atomic_store(tmo, 1u, __ATOMIC_RELAXED, __HIP_MEMORY_SCOPE_AGENT); break; } }
            float q = 0.f;
#pragma unroll
            for (int t = 0; t < 4; ++t) q += (t == u.pn) ? tot : __uint_as_float((unsigned)gq[t]);
            S[row] = __builtin_amdgcn_rsqf(q * (1.0f / 1024.0f) + eps);
        }
        asm volatile("s_waitcnt lgkmcnt(0)" ::: "memory"); __builtin_amdgcn_s_barrier(); asm volatile("" ::: "memory");
    }
};
template <bool HAS_PRE> struct EpiRmsRes {
    static constexpr bool PERM = true, AFTER_DRAIN = true;
    bf16_t* xn; const float* rsi_in; float* rsi_out; float* out; int ldc; const float* g_prev; const float* g_post; float scale; const float* g_pre; RmsStats st1, st2;
    __device__ __forceinline__ void fused(f32x4 (&acc)[2][2][4][2], const Unit& u, int wr, int wc, int fr, int fq, PG8_LAS unsigned char* lds, int wid, int lane) const {
        const PG8_LAS float* S = (const PG8_LAS float*)(lds + 8192);
        const int col0 = u.pn * BM + wc * 32 + 8 * fq;
        u32x4 pre[4][2];
#pragma unroll
        for (int m = 0; m < 4; ++m)
#pragma unroll
            for (int bj = 0; bj < 2; ++bj) pre[m][bj] = *(const u32x4*)((const char*)xn + img_byte(u.pm * BM + wr * 64 + m * 16 + fr, col0 + bj * HALF, ldc));
        st1.run(acc, u, wr, wc, fr, fq, lds, wid, lane);
        f32x4 gp[2][2], gi[2][2];
#pragma unroll
        for (int bj = 0; bj < 2; ++bj)
#pragma unroll
            for (int n = 0; n < 2; ++n) { gp[bj][n] = *(const f32x4*)(g_post + col0 + bj * HALF + 4 * n) * scale; const f32x4 gv = *(const f32x4*)(g_prev + col0 + bj * HALF + 4 * n);
#pragma unroll
                for (int e = 0; e < 4; ++e) gi[bj][n][e] = __builtin_amdgcn_rcpf(gv[e]); }
#pragma unroll
        for (int ai = 0; ai < 2; ++ai)
#pragma unroll
            for (int m = 0; m < 4; ++m) { const int r = ai * HALF + wr * 64 + m * 16 + fr; const float rs = S[r]; const float ri = rsi_in[u.pm * BM + r];
#pragma unroll
                for (int bj = 0; bj < 2; ++bj) { const u32x4 xv = ai == 0 ? pre[m][bj] : *(const u32x4*)((const char*)xn + img_byte(u.pm * BM + r, col0 + bj * HALF, ldc));
                    const f32x4 x0 = (f32x4){bfu_lo(xv.x), bfu_hi(xv.x), bfu_lo(xv.y), bfu_hi(xv.y)}, x1 = (f32x4){bfu_lo(xv.z), bfu_hi(xv.z), bfu_lo(xv.w), bfu_hi(xv.w)};
                    acc[ai][bj][m][0] = x0 * ri * gi[bj][0] + acc[ai][bj][m][0] * rs * gp[bj][0]; acc[ai][bj][m][1] = x1 * ri * gi[bj][1] + acc[ai][bj][m][1] * rs * gp[bj][1]; }
                asm volatile("" : "+v"(acc[ai][0][m][0]), "+v"(acc[ai][0][m][1]), "+v"(acc[ai][1][m][0]), "+v"(acc[ai][1][m][1]));
                if (m == 3) asm volatile("" ::: "memory"); }
        if (HAS_PRE) {
            st2.run(acc, u, wr, wc, fr, fq, lds, wid, lane);
#pragma unroll
            for (int bj = 0; bj < 2; ++bj)
#pragma unroll
                for (int n = 0; n < 2; ++n) gp[bj][n] = *(const f32x4*)(g_pre + col0 + bj * HALF + 4 * n);
        }
#pragma unroll
        for (int ai = 0; ai < 2; ++ai)
#pragma unroll
            for (int m = 0; m < 4; ++m) { const int r = ai * HALF + wr * 64 + m * 16 + fr; const float rs = HAS_PRE ? S[r] : 0.f; const size_t off = (size_t)(u.pm * BM + r) * ldc + col0;
#pragma unroll
                for (int bj = 0; bj < 2; ++bj) { const f32x4 a0 = acc[ai][bj][m][0], a1 = acc[ai][bj][m][1];
                    if (HAS_PRE) { const f32x4 o0 = a0 * rs * gp[bj][0], o1 = a1 * rs * gp[bj][1]; u32x4 w; w.x = cvt_pk_safe(o0[0], o0[1]); w.y = cvt_pk_safe(o0[2], o0[3]); w.z = cvt_pk_safe(o1[0], o1[1]); w.w = cvt_pk_safe(o1[2], o1[3]);
                        *(u32x4*)((char*)xn + img_byte(u.pm * BM + r, col0 + bj * HALF, ldc)) = w; }
                    else { *(f32x4*)(out + off + bj * HALF) = a0; *(f32x4*)(out + off + bj * HALF + 4) = a1; } }
                asm volatile("" ::: "memory"); }
        if (HAS_PRE && u.pn == 0 && lane < 32) { const int row = wid * 32 + lane; rsi_out[u.pm * BM + row] = __builtin_amdgcn_rcpf(S[row]); }
    }
};
}
#define XB_TMO      128
#define XB_XCNT(j)  (256  + 64 * (j))
#define XB_XSUB(j)  (1280 + 64 * (j))
#define XB_XGEN(j)  (2304 + 64 * (j))
#define XB_TOP      3328
#define XB_TOPGEN   3392
#define XCD_BAR_WORDS 3456
#define XB_SPIN_CAP (1u << 18)

__device__ __forceinline__ unsigned xb_ld(unsigned* p)              { return __hip_atomic_load(p, __ATOMIC_RELAXED, __HIP_MEMORY_SCOPE_AGENT); }
__device__ __forceinline__ unsigned xb_add(unsigned* p, unsigned v) { return __hip_atomic_fetch_add(p, v, __ATOMIC_RELAXED, __HIP_MEMORY_SCOPE_AGENT); }
__device__ __forceinline__ unsigned xb_xcc_id() { return (unsigned)__builtin_amdgcn_s_getreg((3 << 11) | 20) & 0xFu; }
#define XB_SPIN(cond, bar) do { unsigned _sp = 0; while (cond) { __builtin_amdgcn_s_sleep(1); \
    if ((++_sp & 255u) == 0u) { if (xb_ld(&(bar)[XB_TMO])) break; if (_sp > XB_SPIN_CAP) { atomicAdd(&(bar)[XB_TMO], 1u); break; } } } } while (0)

struct XcdBarrier {
    unsigned* bar; unsigned x;
    volatile LAS unsigned* st;
};

__device__ __forceinline__ XcdBarrier xcd_barrier_post(unsigned* bar, volatile LAS unsigned* st) {
    XcdBarrier b; b.bar = bar; b.x = xb_xcc_id(); b.st = st;
    if (threadIdx.x == 0) (void)xb_add(&bar[XB_XCNT(b.x)], 1u);
    return b;
}
__device__ __forceinline__ void xcd_barrier_complete(unsigned* bar, unsigned x, unsigned& nloc, unsigned& nx) {
    const unsigned G = gridDim.x * gridDim.y * gridDim.z;
    unsigned sum, cnt, mine, sp = 0u;
    for (;;) {
        sum = 0u; cnt = 0u; mine = 0u;
#pragma unroll
        for (unsigned j = 0; j < 16; ++j) { const unsigned c = xb_ld(&bar[XB_XCNT(j)]); sum += c; cnt += (c > 0u) ? 1u : 0u; mine = (j == x) ? c : mine; }
        if (sum == G) break;
        __builtin_amdgcn_s_sleep(1);
        if ((++sp & 255u) == 0u) { if (xb_ld(&bar[XB_TMO])) break; if (sp > XB_SPIN_CAP) { atomicAdd(&bar[XB_TMO], 1u); break; } }
    }
    nloc = mine > 0u ? mine : 1u; nx = cnt > 0u ? cnt : 1u;
}

__device__ __forceinline__ void xcd_barrier(const XcdBarrier& b) {
    asm volatile("s_waitcnt vmcnt(0)" ::: "memory");
    __syncthreads();
    if (threadIdx.x == 0) {
        unsigned* bar = b.bar;
        __builtin_amdgcn_s_waitcnt(0);
        unsigned nloc = b.st[0], nx = b.st[1];
        if (nloc == 0u) { xcd_barrier_complete(bar, b.x, nloc, nx); b.st[0] = nloc; b.st[1] = nx; }
        const unsigned old = xb_add(&bar[XB_XSUB(b.x)], 1u);
        const unsigned gen = old / nloc;
        if (old + 1u == (gen + 1u) * nloc) {
            __builtin_amdgcn_fence(__ATOMIC_RELEASE, "agent");
            asm volatile("s_waitcnt vmcnt(0)" ::: "memory");
            const unsigned og = xb_add(&bar[XB_TOP], 1u);
            const unsigned tg = og / nx;
            if (og + 1u == (tg + 1u) * nx) { xb_add(&bar[XB_TOPGEN], 1u); xb_add(&bar[XB_XGEN(b.x)], 1u); __builtin_amdgcn_fence(__ATOMIC_ACQUIRE, "agent"); }
            else { __builtin_amdgcn_fence(__ATOMIC_ACQUIRE, "agent");
                   XB_SPIN(xb_ld(&bar[XB_TOPGEN]) == tg, bar);
                   xb_add(&bar[XB_XGEN(b.x)], 1u); }
            asm volatile("s_waitcnt vmcnt(0)" ::: "memory");
        } else {
            __builtin_amdgcn_fence(__ATOMIC_ACQUIRE, "agent");
            XB_SPIN(xb_ld(&bar[XB_XGEN(b.x)]) == gen, bar);
            asm volatile("s_waitcnt vmcnt(0)" ::: "memory");
        }
    }
    __syncthreads();
}

#define XB_XSUB2(j) (3456 + 64 * (j))
#define XB_XGEN2(j) (4480 + 64 * (j))
#define XB_LOG(g)   (5504 + (g))
#define XB_PHY(j)   (5520 + (j))
__device__ __forceinline__ void xcd_local_census_post(const XcdBarrier& b) {
    if (threadIdx.x == 0) { const unsigned g = blockIdx.x & 7u; atomicOr(&b.bar[XB_LOG(g)], 1u << b.x); atomicOr(&b.bar[XB_PHY(b.x)], 1u << g); }
}
__device__ __forceinline__ bool xcd_local_ok(const XcdBarrier& b) {
    bool ok = true;
    for (unsigned g = 0; g < 8; ++g) { const unsigned m = xb_ld(&b.bar[XB_LOG(g)]); ok = ok && (__builtin_popcount(m) == 1); }
    for (unsigned j = 0; j < 16; ++j) { const unsigned m = xb_ld(&b.bar[XB_PHY(j)]); ok = ok && (__builtin_popcount(m) <= 1); }
    return ok;
}
__device__ __forceinline__ void xcd_barrier_local(const XcdBarrier& b) {
    asm volatile("s_waitcnt vmcnt(0)" ::: "memory");
    __syncthreads();
    if (threadIdx.x == 0) {
        unsigned* bar = b.bar;
        __builtin_amdgcn_s_waitcnt(0);
        const unsigned nloc = b.st[0];
        const unsigned old = xb_add(&bar[XB_XSUB2(b.x)], 1u);
        const unsigned gen = old / nloc;
        if (old + 1u == (gen + 1u) * nloc) { xb_add(&bar[XB_XGEN2(b.x)], 1u); __builtin_amdgcn_fence(__ATOMIC_ACQUIRE, "agent"); }
        else { __builtin_amdgcn_fence(__ATOMIC_ACQUIRE, "agent");
               XB_SPIN(xb_ld(&bar[XB_XGEN2(b.x)]) == gen, bar); }
        asm volatile("s_waitcnt vmcnt(0)" ::: "memory");
    }
    __syncthreads();
}
struct Ctx {
    lptr lds; int tid, lane, wave, vcu, G;
    unsigned char* ws; float* out;
};

#define INP(i) ((const float*)(const GAS float*)(*(const LAS unsigned long long*)(C.lds + TAB_OFF + 8 * (i))))
struct TrItem { const float* W; bf16* WT; int K, N, row_off, kb, nb; float scale; };
__device__ __forceinline__ void tr_load(const TrItem& d, float (&wv)[32], int lane) {
    const int k0 = 64 * d.kb, n0 = 32 * d.nb;
#pragma unroll
    for (int i = 0; i < 32; ++i) wv[i] = d.W[(size_t)(k0 + 2 * i + (lane >> 5)) * d.N + n0 + (lane & 31)];
}
__device__ __forceinline__ void tr_store(const TrItem& d, const float (&wv)[32], LAS float* scr, int lane) {
    const int k0 = 64 * d.kb, n0 = 32 * d.nb; const float scale = d.scale;
#pragma unroll
    for (int i = 0; i < 32; ++i) scr[(2 * i + (lane >> 5)) * 33 + (lane & 31)] = wv[i];
    LDS_WAIT(); asm volatile("" ::: "memory");
    const int rr = lane & 15, c4 = lane >> 4;
#pragma unroll
    for (int j = 0; j < 4; ++j) { const int rho = 16 * (j >> 1) + rr, kk = 32 * (j & 1) + 8 * c4; const LAS float* s = scr + kk * 33 + pg8::perm32(rho);
        v4u o; o.x = pk2(scale * s[0 * 33], scale * s[1 * 33]); o.y = pk2(scale * s[2 * 33], scale * s[3 * 33]); o.z = pk2(scale * s[4 * 33], scale * s[5 * 33]); o.w = pk2(scale * s[6 * 33], scale * s[7 * 33]);
        *(GAS v4u*)((GAS char*)d.WT + pg8::img_byte(d.row_off + n0 + rho, k0 + kk, d.K)) = o; }
    LDS_WAIT(); asm volatile("" ::: "memory");
}
#define TR_PIPELINE(NI, DESC) do { if (hw < (NI)) { TrItem cur_ = DESC(hw); float wa_[32]; tr_load(cur_, wa_, C.lane); \
        for (int it = hw; it < (NI); it += NHW) { const int itn_ = it + NHW; const bool hn_ = itn_ < (NI); TrItem nxt_ = cur_; float wb_[32]; \
            if (hn_) { nxt_ = DESC(itn_); tr_load(nxt_, wb_, C.lane); } \
            tr_store(cur_, wa_, scr, C.lane); \
            if (hn_) { _Pragma("unroll") for (int i = 0; i < 32; ++i) wa_[i] = wb_[i]; cur_ = nxt_; } } } } while (0)
__device__ __forceinline__ void conv_ffn(const Ctx& C, int layer, int which, int hw, int NHW) {
    const float* wup = INP(which ? 4 : 2) + (size_t)layer * D * NUP; const float* wdn = INP(which ? 5 : 3) + (size_t)layer * FF * D;
    bf16* WUP = (bf16*)(C.ws + ffn_w_off(layer, which)); bf16* WDN = WUP + (size_t)NUP * D;
    LAS float* scr = (LAS float*)(C.lds + C.wave * 16384);
    constexpr int I_UP = (D / 64) * (NUP / 32), I_DN = (FF / 64) * (D / 32);
    auto desc = [&](int it) -> TrItem {
        if (it < I_UP) { const int nblk = NUP / 32, kb = it / nblk, nb = it % nblk, n0 = 32 * nb;
            const int j0 = n0 < FF ? n0 : n0 - FF; const int dst = (j0 / 128) * 256 + (j0 % 128) + (n0 < FF ? 0 : 128);
            return TrItem{wup, WUP, D, NUP, dst - n0, kb, nb, n0 < FF ? NL2E : NLN2}; }
        const int r = it - I_UP, nblk = D / 32; return TrItem{wdn, WDN, FF, D, 0, r / nblk, r % nblk, 1.0f}; };
    TR_PIPELINE(I_UP + I_DN, desc);
}
__device__ __forceinline__ void conv_mix(const Ctx& C, int layer, int hw, int NHW) {
    const float* win = INP(6) + (size_t)layer * D * WIN; const float* pa = INP(28) + (size_t)layer * RW * D; const float* pb = INP(29) + (size_t)layer * LW * D; const float* wo = INP(30) + (size_t)layer * D * D;
    LAS float* scr = (LAS float*)(C.lds + C.wave * 16384);
    constexpr int I_IN = (D / 64) * (WIN / 32), I_P = (RW / 64) * (D / 32), I_O = (D / 64) * (D / 32);
    auto desc = [&](int it) -> TrItem { int r = it;
        if (r < I_IN) return TrItem{win, (bf16*)(C.ws + WS_WIN), D, WIN, 0, r / (WIN / 32), r % (WIN / 32), 32 * (r % (WIN / 32)) >= NAL ? NL2E : 1.0f};
        r -= I_IN; if (r < I_P) return TrItem{pa, (bf16*)(C.ws + WS_PAT), RW, D, 0, r / (D / 32), r % (D / 32), 1.0f};
        r -= I_P;  if (r < I_P) return TrItem{pb, (bf16*)(C.ws + WS_PBT), LW, D, 0, r / (D / 32), r % (D / 32), 1.0f};
        r -= I_P;  return TrItem{wo, (bf16*)(C.ws + WS_WOT), D, D, 0, r / (D / 32), r % (D / 32), 1.0f}; };
    TR_PIPELINE(I_IN + 2 * I_P + I_O, desc);
    const float* w_up = INP(9) + (size_t)layer * 64 * RW; const float* a_up = INP(11) + (size_t)layer * 64 * RW; const float* g_up = INP(12) + (size_t)layer * 128 * RW;
    const float* lwa = INP(23) + (size_t)layer * 8 * 64 * 64; const float* lwx = INP(25) + (size_t)layer * 8 * 64 * 64;
    bf16* WUT = (bf16*)(C.ws + WS_WUT); bf16* AUT = (bf16*)(C.ws + WS_AUT); bf16* GUT = (bf16*)(C.ws + WS_GUT); bf16* VDT = (bf16*)(C.ws + WS_VDT); bf16* VUT = (bf16*)(C.ws + WS_VUT);
    bf16* LWA = (bf16*)(C.ws + WS_LWA); bf16* LWX = (bf16*)(C.ws + WS_LWX);
    const int gt = hw * 64 + C.lane, NT = NHW * 64;
    for (int i = gt; i < 512 * 64; i += NT) { const int n = i >> 6, k = i & 63; WUT[i] = (bf16)f2bf(w_up[k * RW + n]); AUT[i] = (bf16)f2bf(a_up[k * RW + n]); }
    for (int i = gt; i < 512 * 128; i += NT) { const int n = i >> 7, k = i & 127; GUT[i] = (bf16)f2bf(g_up[k * RW + n]); }
    for (int i = gt; i < 8 * 64 * 64; i += NT) { const int nb = i >> 12, e = (i >> 6) & 63, d = i & 63; LWA[i] = (bf16)f2bf(NL2E * lwa[(nb * 64 + d) * 64 + e]); LWX[i] = (bf16)f2bf(NL2E * lwx[(nb * 64 + d) * 64 + e]); }
    { float* PT = (float*)(C.ws + WS_PT); const float* mu = INP(7) + (size_t)layer * WSH; const float* w0 = INP(8) + layer * RW; const float* a0 = INP(10) + layer * RW;
      const float* k_k = INP(13) + layer * RW; const float* k_a = INP(14) + layer * RW; const float* r_k = INP(15) + layer * RW; const float* v0 = INP(18) + (layer > 0 ? (layer - 1) * RW : 0);
      for (int i = gt; i < RW; i += NT) { *(GAS f32x4*)(PT + i * 12) = (f32x4){mu[i], mu[RW + i], mu[2 * RW + i], w0[i]}; *(GAS f32x4*)(PT + i * 12 + 4) = (f32x4){a0[i], k_k[i], k_a[i], r_k[i]};
          *(GAS f32x4*)(PT + i * 12 + 8) = (f32x4){layer > 0 ? v0[i] : 0.f, 0.f, 0.f, 0.f}; } }
    if (layer > 0) {
        const float* v_down = INP(19) + (size_t)(layer - 1) * RW * 32; const float* v_up = INP(20) + (size_t)(layer - 1) * 32 * RW;
        for (int i = gt; i < 32 * 512; i += NT) { const int n = i >> 9, k = i & 511; VDT[i] = (bf16)f2bf(v_down[k * 32 + n]); }
        for (int i = gt; i < 512 * 32; i += NT) { const int n = i >> 5, k = i & 31; VUT[i] = (bf16)f2bf(v_up[k * RW + n]); }
    }
}

__device__ __forceinline__ void norm_phase(const Ctx& C, const float* xin, const float* g_pre, bf16* xn) {
    const int gw = C.vcu * NWAVES + C.wave, NGW = C.G * NWAVES;
    f32x4 gp[4];
#pragma unroll
    for (int j = 0; j < 4; ++j) gp[j] = *(const GAS f32x4*)(g_pre + 4 * C.lane + 256 * j);
    f32x4 v[2][4];
#pragma unroll
    for (int r = 0; r < 2; ++r)
#pragma unroll
        for (int j = 0; j < 4; ++j) v[r][j] = ((const GAS f32x4*)(xin + (size_t)(2 * gw + r) * D) + C.lane)[64 * j];
    for (int m = 2 * gw; m < M; m += 2 * NGW) {
        f32x4 vn[2][4]; const int mn = m + 2 * NGW;
        if (mn < M) {
#pragma unroll
            for (int r = 0; r < 2; ++r)
#pragma unroll
                for (int j = 0; j < 4; ++j) vn[r][j] = ((const GAS f32x4*)(xin + (size_t)(mn + r) * D) + C.lane)[64 * j]; }
#pragma unroll
        for (int r = 0; r < 2; ++r) { float s2 = 0.f;
#pragma unroll
            for (int j = 0; j < 4; ++j) s2 += (v[r][j][0] * v[r][j][0] + v[r][j][1] * v[r][j][1]) + (v[r][j][2] * v[r][j][2] + v[r][j][3] * v[r][j][3]);
            const float rs2 = __builtin_amdgcn_rsqf(wave_sum(s2, C.lane) * (1.f / D) + RMS_EPS);
            if (C.lane == 0) ((float*)(C.ws + WS_RSI))[m + r] = __builtin_amdgcn_rcpf(rs2);
#pragma unroll
            for (int j = 0; j < 4; ++j) gl_st4((bf16*)((char*)xn + pg8::img_byte(m + r, 4 * C.lane + 256 * j, D)), v[r][j] * rs2 * gp[j]); }
        if (mn < M) {
#pragma unroll
            for (int r = 0; r < 2; ++r)
#pragma unroll
                for (int j = 0; j < 4; ++j) v[r][j] = vn[r][j]; }
    }
}

__device__ __forceinline__ float shifted(const bf16* PA, int m, int col, float mu, bool first) {
    const float p = bf2f(PA[(size_t)m * WSH + col]); const float pp = first ? 0.f : bf2f(PA[(size_t)(m - 1) * WSH + col]);
    return p + mu * (pp - p);
}
enum { SL_XL0 = 0, SL_XL1 = 1, SL_MISC = 2, SL_WL = 3, SL_AP = 4, SL_VM = 5, SL_MRB = 6, SL_AT = 7, SL_ATT = 8, SL_RT = 9, SL_BT = 10, SL_KT = 11, SL_BHT = 12, SL_KHT = 13, SL_VT = 14, SL_TA = 15, SL_MRK = 16, SL_XT = 17 };
enum { SL_L = SL_WL, SL_LT = SL_AP, SL_LAK = SL_VM, SL_L2 = SL_AT, SL_L2T = SL_BT, SL_TB = SL_KT, SL_WUT = SL_WL, SL_U0T = SL_AP, SL_XL2 = SL_WL, SL_XL3 = SL_AP };
#define SLOTP(i) (C.lds + (i) * SLOT)

__device__ __forceinline__ void prepA_phase(const Ctx& C, int layer) {
    const bf16* PA = (const bf16*)(C.ws + WS_PA);
    bf16* VF = (bf16*)(C.ws + WS_VF); bf16* GG = (bf16*)(C.ws + WS_GG); float* BS = (float*)(C.ws + WS_BS);
    bf16* SP = (bf16*)(C.ws + WS_SP); bf16* SQ = (bf16*)(C.ws + WS_SQ); bf16* SR = (bf16*)(C.ws + WS_SR); bf16* SY = (bf16*)(C.ws + WS_SY);
    const bf16* WUT = (const bf16*)(C.ws + WS_WUT); const bf16* AUT = (const bf16*)(C.ws + WS_AUT); const bf16* GUT = (const bf16*)(C.ws + WS_GUT);
    const bf16* VDT = (const bf16*)(C.ws + WS_VDT); const bf16* VUT = (const bf16*)(C.ws + WS_VUT);
    const float* mu = INP(7) + (size_t)layer * WSH;
    const float* PT = (const float*)(C.ws + WS_PT);
    const int lane = C.lane, wave = C.wave, tid = C.tid, r16 = lane & 15, g = lane >> 4;
    LAS float* segtot = (LAS float*)(SLOTP(SL_MISC) + 4096);
    LAS float* gC = (LAS float*)(SLOTP(SL_MISC) + 6144);
    lptr VDm = SLOTP(SL_MISC);

    for (int cidx = C.vcu; cidx < NCHUNK; cidx += C.G) {
        const int m0 = cidx * 64; const bool seq0 = (cidx % NCH_SEQ) == 0;
        bf16x8 gb[4][4];
#pragma unroll
        for (int q = 0; q < 4; ++q)
#pragma unroll
            for (int s = 0; s < 4; ++s) gb[q][s] = gl_frag(GUT + (size_t)(16 * (4 * wave + q) + r16) * 128 + 32 * s + 8 * g);
#pragma unroll
        for (int i = 0; i < 4; ++i) { const int idx = tid + NWAVES * 64 * i, t = idx >> 5, cc = (idx & 31) * 8, col = 3 * RW + cc;
            const v4u cur = *(const GAS v4u*)(PA + (size_t)(m0 + t) * WSH + col);
            v4u prv = (v4u){0u, 0u, 0u, 0u}; if (!(seq0 && t == 0)) prv = *(const GAS v4u*)(PA + (size_t)(m0 + t - 1) * WSH + col);
            const f32x4 mu0 = *(const GAS f32x4*)(mu + col), mu1 = *(const GAS f32x4*)(mu + col + 4);
            const unsigned cw_[4] = {cur.x, cur.y, cur.z, cur.w}, pw_[4] = {prv.x, prv.y, prv.z, prv.w}; float f[8];
#pragma unroll
            for (int e = 0; e < 8; ++e) { const float p = (e & 1) ? bfhi(cw_[e >> 1]) : bflo(cw_[e >> 1]), pp = (e & 1) ? bfhi(pw_[e >> 1]) : bflo(pw_[e >> 1]); const float m_ = e < 4 ? mu0[e] : mu1[e - 4];
                const float val = p + m_ * (pp - p);
                const float sg = sigm(cc < 64 ? 2.0f * val : val);
                f[e] = cc < 64 ? 2.0f * sg - 1.0f : (cc < 128 ? val : sg); }
            const int sl = cc < 64 ? SL_XL0 : (cc < 128 ? SL_XL1 : (cc < 192 ? SL_XL2 : SL_XL3));
            *(LAS v4u*)(SLOTP(sl) + sw_off(t, cc & 63)) = (v4u){pk2(f[0], f[1]), pk2(f[2], f[3]), pk2(f[4], f[5]), pk2(f[6], f[7])}; }
        LDS_BAR();
#pragma unroll
        for (int mt = 0; mt < 4; ++mt) { bf16x8 a[4];
#pragma unroll
            for (int s = 0; s < 4; ++s) a[s] = lds_frag(SLOTP(s < 2 ? SL_XL2 : SL_XL3), 16 * mt + r16, 32 * (s & 1) + 8 * g);
#pragma unroll
            for (int q = 0; q < 4; ++q) { f32x4 acc = (f32x4){0.f, 0.f, 0.f, 0.f};
#pragma unroll
                for (int s = 0; s < 4; ++s) acc = mfma16(gb[q][s], a[s], acc);
                gl_st4(GG + ((size_t)(cidx * NH + wave) * 8 + mt * 2 + (q >> 1)) * 512 + ((2 * (q & 1) + (g >> 1)) * 16 + r16) * 8 + 4 * (g & 1), acc); } }
        LDS_BAR();
        if (layer > 0) {
#pragma unroll 4
            for (int i = 0; i < 8; ++i) { const int idx = tid + NWAVES * 64 * i, t = idx >> 6, c = (idx & 63) * 8, col = 2 * RW + c;
                const v4u cur = *(const GAS v4u*)(PA + (size_t)(m0 + t) * WSH + col);
                v4u prv = (v4u){0u, 0u, 0u, 0u}; if (!(seq0 && t == 0)) prv = *(const GAS v4u*)(PA + (size_t)(m0 + t - 1) * WSH + col);
                const f32x4 mu0 = *(const GAS f32x4*)(mu + col), mu1 = *(const GAS f32x4*)(mu + col + 4);
                const unsigned cw_[4] = {cur.x, cur.y, cur.z, cur.w}, pw_[4] = {prv.x, prv.y, prv.z, prv.w}; float f[8];
#pragma unroll
                for (int e = 0; e < 8; ++e) { const float p = (e & 1) ? bfhi(cw_[e >> 1]) : bflo(cw_[e >> 1]), pp = (e & 1) ? bfhi(pw_[e >> 1]) : bflo(pw_[e >> 1]); const float m_ = e < 4 ? mu0[e] : mu1[e - 4]; f[e] = p + m_ * (pp - p); }
                *(LAS v4u*)(SLOTP(5 + (c >> 6)) + sw_off(t, c & 63)) = (v4u){pk2(f[0], f[1]), pk2(f[2], f[3]), pk2(f[4], f[5]), pk2(f[6], f[7])}; }
            LDS_BAR();
            { const int mt = wave & 3, nt = wave >> 2;
              f32x4 acc = (f32x4){0.f, 0.f, 0.f, 0.f};
#pragma unroll
              for (int blk = 0; blk < 8; ++blk)
#pragma unroll
                  for (int s = 0; s < 2; ++s) { const bf16x8 a = lds_frag(SLOTP(5 + blk), 16 * mt + r16, 32 * s + 8 * g);
                      const bf16x8 b = gl_frag(VDT + (size_t)(16 * nt + r16) * 512 + 64 * blk + 32 * s + 8 * g); acc = mfma16(a, b, acc); }
              LDS_BAR();
#pragma unroll
              for (int i = 0; i < 4; ++i) *(LAS bf16*)(VDm + (16 * mt + 4 * g + i) * 64 + (16 * nt + r16) * 2) = (bf16)f2bf(acc[i]);
            }
            LDS_BAR();
        }
        unsigned rkraw[9], vvraw[9]; bf16x8 wfr[2][2], afr[2][2], vufr[2];
#define PREP_FETCH_RAW(hh) do { const int cg_ = 64 * (hh) + lane0, t0_ = 8 * wave; \
            _Pragma("unroll") for (int u = 0; u < 9; ++u) { const bool z_ = (u == 0) && seq0 && t0_ == 0; const size_t ro_ = (size_t)(m0 + t0_ + u - 1) * WSH; \
                const unsigned r_ = z_ ? 0u : (unsigned)PA[ro_ + cg_], k_ = z_ ? 0u : (unsigned)PA[ro_ + RW + cg_], v_ = z_ ? 0u : (unsigned)PA[ro_ + 2 * RW + cg_]; \
                const unsigned f_ = (layer > 0 && u > 0) ? (unsigned)VF[(size_t)(m0 + t0_ + u - 1) * RW + cg_] : 0u; \
                rkraw[u] = r_ | (k_ << 16); vvraw[u] = v_ | (f_ << 16); } } while (0)
#define PREP_FETCH_W(hh) do { const int ntbp_ = (wave & 1) * 2; \
            _Pragma("unroll") for (int s = 0; s < 2; ++s) _Pragma("unroll") for (int q = 0; q < 2; ++q) { const size_t ro_ = (size_t)(64 * (hh) + 16 * (ntbp_ + q) + r160) * 64 + 32 * s + 8 * g0; wfr[s][q] = gl_frag(WUT + ro_); afr[s][q] = gl_frag(AUT + ro_); } \
            if (layer > 0) { _Pragma("unroll") for (int q = 0; q < 2; ++q) vufr[q] = gl_frag(VUT + (size_t)(64 * (hh) + 16 * (ntbp_ + q) + r160) * 32 + 8 * g0); } } while (0)
#define PREP_FETCH_PAR(hh) do { const GAS float* pp_ = (const GAS float*)(PT + (64 * (hh) + lane0) * 12); const f32x4 p0_ = *(const GAS f32x4*)pp_, p1_ = *(const GAS f32x4*)(pp_ + 4); \
            par[0] = p0_[0]; par[1] = p0_[1]; par[2] = p0_[2]; par[3] = p0_[3]; par[4] = p1_[0]; par[5] = p1_[1]; par[6] = p1_[2]; par[7] = p1_[3]; par[8] = pp_[8]; } while (0)
        float par[9];
        { const int lane0 = lane, r160 = r16, g0 = g; PREP_FETCH_PAR(0); PREP_FETCH_RAW(0); PREP_FETCH_W(0); }
        for (int h = 0; h < NH; ++h) {
            int lane_l = C.lane; asm volatile("" : "+v"(lane_l));
            const int lane = lane_l, r16 = lane & 15, g = lane >> 4;
            const int c0 = 64 * h, ch = lane, cg = c0 + ch, t0 = 8 * wave;
            float rr[8], kr[8], vr[8], vfv[8];
            { const float mur = par[0], muk = par[1], muv = par[2];
#pragma unroll
              for (int u = 0; u < 8; ++u) { const float pr = bflo(rkraw[u]), pk = bfhi(rkraw[u]), pv = bflo(vvraw[u]), cr = bflo(rkraw[u + 1]), ck = bfhi(rkraw[u + 1]), cv = bflo(vvraw[u + 1]);
                  rr[u] = cr + mur * (pr - cr); kr[u] = ck + muk * (pk - ck); vr[u] = cv + muv * (pv - cv); vfv[u] = bfhi(vvraw[u + 1]); } }
            { const int mt = wave >> 1, ntb = (wave & 1) * 2;
              f32x4 aw[2], aa[2]; ZERO2(aw); ZERO2(aa);
#pragma unroll
              for (int s = 0; s < 2; ++s) { const bf16x8 x0 = lds_frag(SLOTP(SL_XL0), 16 * mt + r16, 32 * s + 8 * g), x1 = lds_frag(SLOTP(SL_XL1), 16 * mt + r16, 32 * s + 8 * g);
#pragma unroll
                  for (int q = 0; q < 2; ++q) { aw[q] = mfma16(x0, wfr[s][q], aw[q]); aa[q] = mfma16(x1, afr[s][q], aa[q]); } }
#pragma unroll
              for (int q = 0; q < 2; ++q) { lds_st4(SLOTP(SL_WL), 16 * (ntb + q) + r16, 16 * mt + 4 * g, aw[q]); lds_st4(SLOTP(SL_AP), 16 * (ntb + q) + r16, 16 * mt + 4 * g, aa[q]); }
              if (layer > 0) {
                  const bf16x8 xv = *(const LAS bf16x8*)(VDm + (16 * mt + r16) * 64 + 16 * g);
#pragma unroll
                  for (int q = 0; q < 2; ++q) { f32x4 av = (f32x4){0.f, 0.f, 0.f, 0.f}; av = mfma16(xv, vufr[q], av); lds_st4(SLOTP(SL_VM), 16 * (ntb + q) + r16, 16 * mt + 4 * g, av); }
              } }
            LDS_BAR();
            float lw[8], cs[8];
            { const float w0c = par[3]; float run = 0.f;
              const v4u wl8 = *(const LAS v4u*)(SLOTP(SL_WL) + sw_off(ch, t0)); const unsigned wlw[4] = {wl8.x, wl8.y, wl8.z, wl8.w};
#pragma unroll
              for (int u = 0; u < 8; ++u) {
                  const float z = w0c + ((u & 1) ? bfhi(wlw[u >> 1]) : bflo(wlw[u >> 1]));
                  lw[u] = -0.6065306597126334f * sigm(z); run += lw[u]; cs[u] = run; }
              segtot[wave * 64 + ch] = run; }
            LDS_BAR();
            { float pre = 0.f, tot = 0.f;
#pragma unroll
              for (int s = 0; s < 8; ++s) { const float x = segtot[s * 64 + ch]; tot += x; pre += (s < wave) ? x : 0.f; }
              const float a0c = par[4], kkc = par[5], kac = par[6], rkc = par[7], v0c = par[8];
              float atr[8], bhr[8], khr[8], v2[8]; float ecp = __expf(pre); const float etot = __expf(tot); if (wave == 0) gC[ch] = etot;
              const v4u ap8 = *(const LAS v4u*)(SLOTP(SL_AP) + sw_off(ch, t0)); const unsigned apw[4] = {ap8.x, ap8.y, ap8.z, ap8.w};
              v4u vm8 = (v4u){0u, 0u, 0u, 0u}; if (layer > 0) vm8 = *(const LAS v4u*)(SLOTP(SL_VM) + sw_off(ch, t0)); const unsigned vmw[4] = {vm8.x, vm8.y, vm8.z, vm8.w};
              float agv[8], kkrv[8], k2v[8], n2v[8];
              const lptr RED = SLOTP(SL_TA) + wave * 2560;
#pragma unroll
              for (int u = 0; u < 8; ++u) { agv[u] = sigm(a0c + ((u & 1) ? bfhi(apw[u >> 1]) : bflo(apw[u >> 1]))); kkrv[u] = kr[u] * kkc; k2v[u] = kr[u] * (1.0f + (agv[u] - 1.0f) * kac);
                  *(LAS float*)(RED + u * 288 + lane * 4) = kkrv[u] * kkrv[u]; }
              LDS_WAIT(); asm volatile("" ::: "memory");
              { const f32x4 r0 = *(const LAS f32x4*)(RED + (lane >> 3) * 288 + (lane & 7) * 32), r1 = *(const LAS f32x4*)(RED + (lane >> 3) * 288 + (lane & 7) * 32 + 16);
                float sq = ((r0[0] + r0[1]) + (r0[2] + r0[3])) + ((r1[0] + r1[1]) + (r1[2] + r1[3]));
                sq = DPP_ADD(sq, 0xB1); sq = DPP_ADD(sq, 0x4E); sq = DPP_ADD(sq, 0x141);
                LDS_WAIT(); asm volatile("" ::: "memory");
                *(LAS float*)(RED + 2304 + (lane >> 3) * 4) = sq; }
#pragma unroll
              for (int u = 0; u < 8; ++u) *(LAS float*)(RED + u * 288 + lane * 4) = rr[u] * k2v[u] * rkc;
              LDS_WAIT(); asm volatile("" ::: "memory");
              { const f32x4 t0_ = *(const LAS f32x4*)(RED + 2304), t1_ = *(const LAS f32x4*)(RED + 2304 + 16);
#pragma unroll
                for (int u = 0; u < 4; ++u) { n2v[u] = t0_[u]; n2v[4 + u] = t1_[u]; }
                const f32x4 r0 = *(const LAS f32x4*)(RED + (lane >> 3) * 288 + (lane & 7) * 32), r1 = *(const LAS f32x4*)(RED + (lane >> 3) * 288 + (lane & 7) * 32 + 16);
                float sb = ((r0[0] + r0[1]) + (r0[2] + r0[3])) + ((r1[0] + r1[1]) + (r1[2] + r1[3]));
                sb = DPP_ADD(sb, 0xB1); sb = DPP_ADD(sb, 0x4E); sb = DPP_ADD(sb, 0x141);
                if ((lane & 7) == 0) BS[(size_t)(m0 + t0 + (lane >> 3)) * NH + h] = sb; }
#pragma unroll
              for (int u = 0; u < 8; ++u) { const int t = t0 + u;
                  const float ag = agv[u], kkr = kkrv[u], n2 = n2v[u];
                  const float kk = kkr * __builtin_amdgcn_rsqf(fmaxf(n2, 1e-24f));
                  const float k2 = k2v[u], av = -kk, bv = kk * ag;
                  float vv = vr[u];
                  if (layer > 0) vv = vv + (vfv[u] - vv) * sigm(v0c + ((u & 1) ? bfhi(vmw[u >> 1]) : bflo(vmw[u >> 1])));
                  const unsigned vb = f2bf(vv); v2[u] = bf2f(vb); VF[(size_t)(m0 + t) * RW + cg] = (bf16)vb;
                  const float c = pre + cs[u];
                  const float ec = __expf(c), em = ecp, en = __builtin_amdgcn_rcpf(ec), eh = etot * en; ecp = ec;
                  atr[u] = av * em; bhr[u] = bv * eh; khr[u] = k2 * eh;
                  lds_st16(SLOTP(SL_AT), t, ch, atr[u]); lds_st16(SLOTP(SL_RT), t, ch, rr[u] * ec); lds_st16(SLOTP(SL_BT), t, ch, bv * en); lds_st16(SLOTP(SL_KT), t, ch, k2 * en); }
              v4u w;
              w.x = pk2(atr[0], atr[1]); w.y = pk2(atr[2], atr[3]); w.z = pk2(atr[4], atr[5]); w.w = pk2(atr[6], atr[7]); *(LAS v4u*)(SLOTP(SL_ATT) + sw_off(ch, t0)) = w;
              w.x = pk2(bhr[0], bhr[1]); w.y = pk2(bhr[2], bhr[3]); w.z = pk2(bhr[4], bhr[5]); w.w = pk2(bhr[6], bhr[7]); *(LAS v4u*)(SLOTP(SL_BHT) + sw_off(ch, t0)) = w;
              w.x = pk2(khr[0], khr[1]); w.y = pk2(khr[2], khr[3]); w.z = pk2(khr[4], khr[5]); w.w = pk2(khr[6], khr[7]); *(LAS v4u*)(SLOTP(SL_KHT) + sw_off(ch, t0)) = w;
              w.x = pk2(v2[0], v2[1]); w.y = pk2(v2[2], v2[3]); w.z = pk2(v2[4], v2[5]); w.w = pk2(v2[6], v2[7]); *(LAS v4u*)(SLOTP(SL_VT) + sw_off(ch, t0)) = w; }
            LDS_BAR();
            if (h + 1 < NH) { const int lane0 = lane; PREP_FETCH_PAR(h + 1); PREP_FETCH_RAW(h + 1); }
            const int mt = wave >> 1, ntb = (wave & 1) * 2;
            { f32x4 abn[2], ab[2], ak[2], rb[2], rk[2]; ZERO2(abn); ZERO2(ab); ZERO2(ak); ZERO2(rb); ZERO2(rk);
              mma64_both(abn, ab, SLOTP(SL_AT), SLOTP(SL_BT), mt, ntb, lane); mma64<true>(ak, SLOTP(SL_AT), SLOTP(SL_KT), mt, ntb, lane);
              mma64<true>(rb, SLOTP(SL_RT), SLOTP(SL_BT), mt, ntb, lane); mma64<true>(rk, SLOTP(SL_RT), SLOTP(SL_KT), mt, ntb, lane);
              const int row = 16 * mt + r16;
#pragma unroll
              for (int q = 0; q < 2; ++q) { const int c4 = 16 * (ntb + q) + 4 * g, colN = 16 * (ntb + q) + r16; f32x4 l4, t4, k4, b4, r4, lt4;
#pragma unroll
                  for (int i = 0; i < 4; ++i) { const int col = c4 + i;
                      l4[i] = row > col ? ab[q][i] : 0.f; t4[i] = l4[i] + (row == col ? 1.f : 0.f); k4[i] = row > col ? ak[q][i] : 0.f; b4[i] = row >= col ? rb[q][i] : 0.f; r4[i] = row >= col ? rk[q][i] : 0.f;
                      lt4[i] = (16 * mt + 4 * g + i) > colN ? abn[q][i] : 0.f; }
                  lds_st4(SLOTP(SL_L), row, c4, l4); lds_st4(SLOTP(SL_TA), row, c4, t4); lds_st4(SLOTP(SL_LAK), row, c4, k4); lds_st4(SLOTP(SL_MRB), row, c4, b4); lds_st4(SLOTP(SL_MRK), row, c4, r4);
                  lds_st4(SLOTP(SL_LT), colN, 16 * mt + 4 * g, lt4); } }
            LDS_BAR();
#define SQUARE(src, srcT, dst, dstT) do { f32x4 sqn[2], sqs[2]; ZERO2(sqn); ZERO2(sqs); mma64_both(sqn, sqs, SLOTP(src), SLOTP(srcT), mt, ntb, lane); \
              _Pragma("unroll") for (int q = 0; q < 2; ++q) { lds_st4(SLOTP(dst), 16 * mt + r16, 16 * (ntb + q) + 4 * g, sqs[q]); lds_st4(SLOTP(dstT), 16 * (ntb + q) + r16, 16 * mt + 4 * g, sqn[q]); } } while (0)
#define TUPDATE(tsrc, lT, tdst) do { f32x4 tu[2]; \
              _Pragma("unroll") for (int q = 0; q < 2; ++q) tu[q] = lds_ld4(SLOTP(tsrc), 16 * mt + r16, 16 * (ntb + q) + 4 * g); \
              mma64<true>(tu, SLOTP(tsrc), SLOTP(lT), mt, ntb, lane); \
              _Pragma("unroll") for (int q = 0; q < 2; ++q) lds_st4(SLOTP(tdst), 16 * mt + r16, 16 * (ntb + q) + 4 * g, tu[q]); } while (0)
#define TUP_SQ(tsrc, tdst, src, srcT, dst, dstT) do { f32x4 tu[2], sqn[2], sqs[2]; ZERO2(sqn); ZERO2(sqs); \
              _Pragma("unroll") for (int q = 0; q < 2; ++q) tu[q] = lds_ld4(SLOTP(tsrc), 16 * mt + r16, 16 * (ntb + q) + 4 * g); \
              _Pragma("unroll") for (int s_ = 0; s_ < 2; ++s_) { const bf16x8 at_ = lds_frag(SLOTP(tsrc), 16 * mt + r16, 32 * s_ + 8 * g), al_ = lds_frag(SLOTP(src), 16 * mt + r16, 32 * s_ + 8 * g); \
                  _Pragma("unroll") for (int q = 0; q < 2; ++q) { const bf16x8 b_ = lds_frag(SLOTP(srcT), 16 * (ntb + q) + r16, 32 * s_ + 8 * g); \
                      tu[q] = mfma16(b_, at_, tu[q]); sqn[q] = mfma16(al_, b_, sqn[q]); sqs[q] = mfma16(b_, al_, sqs[q]); } } \
              _Pragma("unroll") for (int q = 0; q < 2; ++q) { lds_st4(SLOTP(tdst), 16 * mt + r16, 16 * (ntb + q) + 4 * g, tu[q]); \
                  lds_st4(SLOTP(dst), 16 * mt + r16, 16 * (ntb + q) + 4 * g, sqs[q]); lds_st4(SLOTP(dstT), 16 * (ntb + q) + r16, 16 * mt + 4 * g, sqn[q]); } } while (0)
            { SQUARE(SL_L, SL_LT, SL_L2, SL_L2T);
              f32x4 x[2]; ZERO2(x); mma64<false>(x, SLOTP(SL_LAK), SLOTP(SL_VT), mt, ntb, lane);
#pragma unroll
              for (int q = 0; q < 2; ++q) lds_st4(SLOTP(SL_XT), 16 * (ntb + q) + r16, 16 * mt + 4 * g, x[q]); }
            LDS_BAR();
            TUP_SQ(SL_TA, SL_TB, SL_L2, SL_L2T, SL_L, SL_LT);
            LDS_BAR();
            TUP_SQ(SL_TB, SL_TA, SL_L, SL_LT, SL_L2, SL_L2T);
            LDS_BAR();
            TUP_SQ(SL_TA, SL_TB, SL_L2, SL_L2T, SL_L, SL_LT);
            LDS_BAR();
            TUP_SQ(SL_TB, SL_TA, SL_L, SL_LT, SL_L2, SL_L2T);
            LDS_BAR();
            TUPDATE(SL_TA, SL_L2T, SL_TB);
            LDS_BAR();
            { f32x4 wu[2], u0[2]; ZERO2(wu); ZERO2(u0);
              mma64<false>(wu, SLOTP(SL_TB), SLOTP(SL_ATT), mt, ntb, lane); mma64<false>(u0, SLOTP(SL_TB), SLOTP(SL_XT), mt, ntb, lane);
#pragma unroll
              for (int q = 0; q < 2; ++q) { lds_st4(SLOTP(SL_WUT), 16 * (ntb + q) + r16, 16 * mt + 4 * g, wu[q]); lds_st4(SLOTP(SL_U0T), 16 * (ntb + q) + r16, 16 * mt + 4 * g, u0[q]); } }
            LDS_BAR();
            if (h + 1 < NH) { const int r160 = r16, g0 = g; PREP_FETCH_W(h + 1); }
            { const size_t cb = ((size_t)cidx * NH + h) * 4096;
              f32x4 re[2], y0[2], pp[2], qq[2]; ZERO2(y0); ZERO2(pp); ZERO2(qq);
#pragma unroll
              for (int q = 0; q < 2; ++q) re[q] = lds_ld4(SLOTP(SL_RT), 16 * mt + r16, 16 * (ntb + q) + 4 * g);
              mma64<true>(re, SLOTP(SL_MRB), SLOTP(SL_WUT), mt, ntb, lane);
              mma64<true>(y0, SLOTP(SL_MRB), SLOTP(SL_U0T), mt, ntb, lane); mma64<true>(y0, SLOTP(SL_MRK), SLOTP(SL_VT), mt, ntb, lane);
              mma64<true>(pp, SLOTP(SL_BHT), SLOTP(SL_WUT), mt, ntb, lane);
              mma64<false>(qq, SLOTP(SL_BHT), SLOTP(SL_U0T), mt, ntb, lane); mma64<false>(qq, SLOTP(SL_KHT), SLOTP(SL_VT), mt, ntb, lane);
              const int row = 16 * mt + r16;
#pragma unroll
              for (int q = 0; q < 2; ++q) { const int cq = 16 * (ntb + q) + 4 * g;
#pragma unroll
                  for (int i = 0; i < 4; ++i) pp[q][i] += (row == cq + i) ? gC[row] : 0.f;
                  { const size_t pl_ = ((size_t)(mt * 2 + ((ntb + q) >> 1)) * 64 + (2 * ((ntb + q) & 1) + (g >> 1)) * 16 + r16) * 8 + 4 * (g & 1);
                    gl_st4(SR + cb + pl_, re[q]); gl_st4(SY + cb + pl_, y0[q]); }
                  gl_st4(SP + cb + ((mt * 2 + ((ntb + q) >> 1)) * 64 + lane) * 8 + 4 * ((ntb + q) & 1), pp[q]);
                  gl_st4(SQ + cb + (((ntb + q) * 2 + (mt >> 1)) * 64 + lane) * 8 + 4 * (mt & 1), qq[q]); } }
            LDS_BAR();
        }
    }
}

constexpr int SB_NSLOT = 12, SB_SLOT = 12288, SB_NLD = 3, SB_LBASE = 64;
__device__ __forceinline__ void glds16_asm(const void* gsrc, unsigned lds_dst) { unsigned keep;
    asm volatile("s_mov_b32 %0, m0\n\ts_mov_b32 m0, %2\n\ts_nop 0\n\tglobal_load_lds_dwordx4 %1, off\n\ts_mov_b32 m0, %0" : "=&s"(keep) : "v"(gsrc), "s"(lds_dst) : "memory"); }
constexpr int SB_RSET = 5;
__device__ __forceinline__ void stageB_loader(const Ctx& C, int layer, int bh, int vs, int par) {
    const bf16* SP = (const bf16*)(C.ws + WS_SP); const bf16* SQ = (const bf16*)(C.ws + WS_SQ);
    const int lane = C.lane, r16 = lane & 15, g = lane >> 4, b = bh >> 3, h = bh & 7, v0 = 16 * vs, base = layer * NCH_SEQ, hbase = layer * SB_LBASE;
    const bf16* spl = SP + ((size_t)(b * NCH_SEQ) * NH + h) * 4096 + lane * 8;
    const bf16* sql = SQ + ((size_t)(b * NCH_SEQ) * NH + h) * 4096 + vs * 1024 + lane * 8;
    volatile LAS unsigned* RDY = (volatile LAS unsigned*)(C.lds + MISC_OFF) + 16 + par; volatile LAS unsigned* DONE = (volatile LAS unsigned*)(C.lds + MISC_OFF) + 20;
    v4u R[SB_RSET][10];
#define SB_LOAD(set, cc) do { const size_t co_ = (size_t)(cc) * NH * 4096; \
        _Pragma("unroll") for (int pc = 0; pc < 8; ++pc) R[set][pc] = *(const GAS v4u*)(spl + co_ + pc * 512); \
        R[set][8] = *(const GAS v4u*)(sql + co_); R[set][9] = *(const GAS v4u*)(sql + co_ + 512); } while (0)
#pragma unroll
    for (int k = 0; k < SB_RSET; ++k) { const int c = par + SB_NLD * k; if (c < NCH_SEQ) SB_LOAD(k, c); }
#pragma unroll 1
    for (int kb = 0; par + SB_NLD * kb < NCH_SEQ; kb += SB_RSET) {
#pragma unroll
        for (int k = 0; k < SB_RSET; ++k) { const int kk = kb + k, c = par + SB_NLD * kk;
            if (c < NCH_SEQ) {
                if (c >= SB_NSLOT) { const unsigned need = (unsigned)(base + c - SB_NSLOT + 1); while (*DONE < need) __builtin_amdgcn_s_sleep(1); asm volatile("" ::: "memory"); }
                const lptr dst = C.lds + (c % SB_NSLOT) * SB_SLOT + lane * 16;
#pragma unroll
                for (int pc = 0; pc < 8; ++pc) *(LAS v4u*)(dst + pc * 1024) = R[k][pc];
#pragma unroll
                for (int q = 0; q < 2; ++q) { const v4u w_ = R[k][8 + q];
                    *(LAS v4u*)(dst + (8 + 2 * q) * 1024) = (v4u){w_.x << 16, w_.x & 0xffff0000u, w_.y << 16, w_.y & 0xffff0000u};
                    *(LAS v4u*)(dst + (9 + 2 * q) * 1024) = (v4u){w_.z << 16, w_.z & 0xffff0000u, w_.w << 16, w_.w & 0xffff0000u}; }
                asm volatile("s_waitcnt lgkmcnt(0)" ::: "memory"); if (lane == 0) *RDY = (unsigned)(hbase + kk + 1);
                const int cn = c + SB_NLD * SB_RSET; if (cn < NCH_SEQ) SB_LOAD(k, cn);
            } }
    }
#undef SB_LOAD
}
__device__ __forceinline__ void stageB_consumer(const Ctx& C, int layer, int bh, int vs) {
    bf16* HC = (bf16*)(C.ws + WS_HC);
    const int lane = C.lane, r16 = lane & 15, g = lane >> 4, b = bh >> 3, h = bh & 7, v0 = 16 * vs, base = layer * NCH_SEQ;
    volatile LAS unsigned* RDY = (volatile LAS unsigned*)(C.lds + MISC_OFF) + 16; volatile LAS unsigned* DONE = (volatile LAS unsigned*)(C.lds + MISC_OFF) + 20; const int hbase = layer * SB_LBASE;
    f32x4 acc[4];
#pragma unroll
    for (int k = 0; k < 4; ++k) acc[k] = (f32x4){0.f, 0.f, 0.f, 0.f};
    const int vch = v0 + r16;
    bf16* hcl = HC + ((size_t)(b * NCH_SEQ) * NH + h) * 4096 + (2 * (vch >> 5) + ((vch >> 2) & 1)) * 1024 + (g >> 1) * 128 + (4 * ((vch >> 3) & 3) + (vch & 3)) * 8 + 4 * (g & 1);
    const lptr sl0 = C.lds + lane * 16;
#define SB_READ(F, Q, SL, RC, PAR, NEED) do { const unsigned need_ = (unsigned)(NEED); if (RC < need_) { do { RC = RDY[PAR]; } while (RC < need_); } asm volatile("" ::: "memory"); \
        _Pragma("unroll") for (int mt = 0; mt < 4; ++mt) _Pragma("unroll") for (int s_ = 0; s_ < 2; ++s_) F[mt][s_] = *(const LAS v4u*)(sl0 + (SL) * SB_SLOT + (mt * 2 + s_) * 1024); \
        _Pragma("unroll") for (int mt = 0; mt < 4; ++mt) Q[mt] = *(const LAS f32x4*)(sl0 + (SL) * SB_SLOT + (8 + mt) * 1024); } while (0)
#define SB_PIN(F, Q) do { _Pragma("unroll") for (int mt = 0; mt < 4; ++mt) asm volatile("" : "+v"(F[mt][0]), "+v"(F[mt][1]), "+v"(Q[mt])); asm volatile("" ::: "memory"); } while (0)
#define SB_STEP(cb, k, F, Q, Fn, Qn, RCn, HASNEXT) do { \
        if (HASNEXT) SB_READ(Fn, Qn, ((k) + 1) % SB_NSLOT, RCn, ((k) + 1) % SB_NLD, hbase + (cb) / SB_NLD + ((k) + 1) / SB_NLD + 1); \
        __builtin_amdgcn_sched_barrier(0); \
        const size_t co_ = (size_t)((cb) + (k)) * NH * 4096; v2u hb_[4]; \
        _Pragma("unroll") for (int kt = 0; kt < 4; ++kt) { hb_[kt].x = pk2(acc[kt][0], acc[kt][1]); hb_[kt].y = pk2(acc[kt][2], acc[kt][3]); } \
        bf16x8 bfr_[2]; \
        _Pragma("unroll") for (int s_ = 0; s_ < 2; ++s_) { const v4u w_ = (v4u){hb_[2 * s_].x, hb_[2 * s_].y, hb_[2 * s_ + 1].x, hb_[2 * s_ + 1].y}; bfr_[s_] = __builtin_bit_cast(bf16x8, w_); } \
        _Pragma("unroll") for (int mt = 0; mt < 4; ++mt) acc[mt] = mfma16(__builtin_bit_cast(bf16x8, F[mt][0]), bfr_[0], Q[mt]); \
        _Pragma("unroll") for (int mt = 0; mt < 4; ++mt) acc[mt] = mfma16(__builtin_bit_cast(bf16x8, F[mt][1]), bfr_[1], acc[mt]); \
        _Pragma("unroll") for (int kt = 0; kt < 4; ++kt) *(GAS v2u*)(hcl + co_ + 256 * kt) = hb_[kt]; \
        __builtin_amdgcn_sched_barrier(0); \
        if (HASNEXT) { SB_PIN(Fn, Qn); if (lane == 0) *DONE = (unsigned)(base + (cb) + (k) + 2); } } while (0)
    v4u FA[4][2], FB[4][2]; f32x4 QA[4], QB[4];
    unsigned rc0 = 0u, rc1 = 0u, rc2 = 0u;
    static_assert(SB_NLD == 3 && SB_NSLOT == 12 && NCH_SEQ == 128, "the step loop below is unrolled over the ring");
    SB_READ(FA, QA, 0, rc0, 0, hbase + 1);
    SB_PIN(FA, QA); if (lane == 0) *DONE = (unsigned)(base + 1);
#pragma unroll 1
    for (int cb = 0; cb < 120; cb += 12) {
        SB_STEP(cb, 0, FA, QA, FB, QB, rc1, true); SB_STEP(cb, 1, FB, QB, FA, QA, rc2, true); SB_STEP(cb, 2, FA, QA, FB, QB, rc0, true);
        SB_STEP(cb, 3, FB, QB, FA, QA, rc1, true); SB_STEP(cb, 4, FA, QA, FB, QB, rc2, true); SB_STEP(cb, 5, FB, QB, FA, QA, rc0, true);
        SB_STEP(cb, 6, FA, QA, FB, QB, rc1, true); SB_STEP(cb, 7, FB, QB, FA, QA, rc2, true); SB_STEP(cb, 8, FA, QA, FB, QB, rc0, true);
        SB_STEP(cb, 9, FB, QB, FA, QA, rc1, true); SB_STEP(cb, 10, FA, QA, FB, QB, rc2, true); SB_STEP(cb, 11, FB, QB, FA, QA, rc0, true);
    }
    { constexpr int cb = 120;
        SB_STEP(cb, 0, FA, QA, FB, QB, rc1, true); SB_STEP(cb, 1, FB, QB, FA, QA, rc2, true); SB_STEP(cb, 2, FA, QA, FB, QB, rc0, true);
        SB_STEP(cb, 3, FB, QB, FA, QA, rc1, true); SB_STEP(cb, 4, FA, QA, FB, QB, rc2, true); SB_STEP(cb, 5, FB, QB, FA, QA, rc0, true);
        SB_STEP(cb, 6, FA, QA, FB, QB, rc1, true); SB_STEP(cb, 7, FB, QB, FA, QA, rc2, false);
    }
#undef SB_READ
#undef SB_STEP
#undef SB_PIN
}

__device__ __forceinline__ void stageC_wave(const Ctx& C, int layer, int ci) {
    const bf16* SR = (const bf16*)(C.ws + WS_SR); const bf16* SY = (const bf16*)(C.ws + WS_SY); const bf16* HC = (const bf16*)(C.ws + WS_HC);
    const bf16* VF = (const bf16*)(C.ws + WS_VF); const bf16* GG = (const bf16*)(C.ws + WS_GG); const float* BS = (const float*)(C.ws + WS_BS); bf16* OA = (bf16*)(C.ws + WS_OA);
    const float* ln_w = INP(16) + layer * RW; const float* ln_b = INP(17) + layer * RW;
    int lane_l = C.lane; asm volatile("" : "+v"(lane_l));
    const int lane = lane_l, r16 = lane & 15, g = lane >> 4, cidx = ci >> 3, h = ci & 7, m0 = cidx * 64;
    const size_t cb = (size_t)ci * 4096;
    bf16x8 hb[4][2];
#pragma unroll
    for (int nt = 0; nt < 4; ++nt)
#pragma unroll
        for (int s = 0; s < 2; ++s) hb[nt][s] = gl_frag(HC + cb + ((nt * 2 + s) * 64 + lane) * 8);
    f32x4 lw4[4], lb4[4];
#pragma unroll
    for (int nt = 0; nt < 4; ++nt) { const int c4 = 64 * h + 32 * (nt >> 1) + 8 * g + 4 * (nt & 1); lw4[nt] = *(const GAS f32x4*)(ln_w + c4); lb4[nt] = *(const GAS f32x4*)(ln_b + c4); }
#pragma unroll 1
    for (int hf = 0; hf < 2; ++hf) {
        v4u ysy[2][2], vfv[2][2], ggv[2][2]; bf16x8 ar[2][2]; float bsv[2];
#pragma unroll
        for (int m = 0; m < 2; ++m) { const int t = 16 * (2 * hf + m) + r16;
#pragma unroll
            for (int p2 = 0; p2 < 2; ++p2) ysy[m][p2] = *(const GAS v4u*)(SY + cb + (((2 * hf + m) * 2 + p2) * 64 + lane) * 8);
#pragma unroll
            for (int s = 0; s < 2; ++s) ar[m][s] = gl_frag(SR + cb + (((2 * hf + m) * 2 + s) * 64 + lane) * 8);
            bsv[m] = BS[(size_t)(m0 + t) * NH + h];
#pragma unroll
            for (int p2 = 0; p2 < 2; ++p2) { const size_t go = (size_t)(m0 + t) * RW + 64 * h + 32 * p2 + 8 * g; vfv[m][p2] = *(const GAS v4u*)(VF + go); ggv[m][p2] = *(const GAS v4u*)(GG + cb + (((2 * hf + m) * 2 + p2) * 64 + lane) * 8); } }
#pragma unroll
        for (int m = 0; m < 2; ++m) { const int t = 16 * (2 * hf + m) + r16;
            f32x4 y[4];
#pragma unroll
            for (int p2 = 0; p2 < 2; ++p2) { y[2 * p2] = (f32x4){bflo(ysy[m][p2].x), bfhi(ysy[m][p2].x), bflo(ysy[m][p2].y), bfhi(ysy[m][p2].y)}; y[2 * p2 + 1] = (f32x4){bflo(ysy[m][p2].z), bfhi(ysy[m][p2].z), bflo(ysy[m][p2].w), bfhi(ysy[m][p2].w)}; }
#pragma unroll
            for (int s = 0; s < 2; ++s)
#pragma unroll
                for (int nt = 0; nt < 4; ++nt) y[nt] = mfma16(hb[nt][s], ar[m][s], y[nt]);
            float s1 = 0.f;
#pragma unroll
            for (int nt = 0; nt < 4; ++nt) s1 += (y[nt][0] + y[nt][1]) + (y[nt][2] + y[nt][3]);
            s1 += bperm(s1, lane ^ 16); s1 += bperm(s1, lane ^ 32);
            const float mean = s1 * (1.f / 64.f); float s2 = 0.f;
#pragma unroll
            for (int nt = 0; nt < 4; ++nt) { y[nt] = y[nt] - mean; s2 += (y[nt][0] * y[nt][0] + y[nt][1] * y[nt][1]) + (y[nt][2] * y[nt][2] + y[nt][3] * y[nt][3]); }
            s2 += bperm(s2, lane ^ 16); s2 += bperm(s2, lane ^ 32);
            const float rstd = __builtin_amdgcn_rsqf(s2 * (1.f / 64.f) + GN_EPS);
            const float bs = bsv[m];
#pragma unroll
            for (int p2 = 0; p2 < 2; ++p2) { const size_t go = (size_t)(m0 + t) * RW + 64 * h + 32 * p2 + 8 * g;
                const v4u vw = vfv[m][p2], gw = ggv[m][p2];
                const f32x4 v0 = (f32x4){bflo(vw.x), bfhi(vw.x), bflo(vw.y), bfhi(vw.y)}, v1 = (f32x4){bflo(vw.z), bfhi(vw.z), bflo(vw.w), bfhi(vw.w)};
                const f32x4 g0 = (f32x4){bflo(gw.x), bfhi(gw.x), bflo(gw.y), bfhi(gw.y)}, g1 = (f32x4){bflo(gw.z), bfhi(gw.z), bflo(gw.w), bfhi(gw.w)};
                const f32x4 o0 = (y[2 * p2] * rstd * lw4[2 * p2] + lb4[2 * p2] + bs * v0) * g0, o1 = (y[2 * p2 + 1] * rstd * lw4[2 * p2 + 1] + lb4[2 * p2 + 1] + bs * v1) * g1;
                *(GAS v4u*)((GAS char*)OA + pg8::img_byte(m0 + t, 64 * h + 32 * p2 + 8 * g, RW)) = (v4u){pk2(o0[0], o0[1]), pk2(o0[2], o0[3]), pk2(o1[0], o1[1]), pk2(o1[2], o1[3])}; }
        }
    }
}

__device__ __forceinline__ void lru_tile_wave(const Ctx& C, int layer, int item, int half) {
    const bf16* PL = (const bf16*)(C.ws + WS_PL); bf16* HL = (bf16*)(C.ws + WS_HL); bf16* AP = (bf16*)(C.ws + WS_AP); float* AGG = (float*)(C.ws + WS_AGG);
    const bf16* LWA = (const bf16*)(C.ws + WS_LWA); const bf16* LWX = (const bf16*)(C.ws + WS_LWX);
    const float* cw = INP(21) + (size_t)layer * 4 * LW; const float* cbias = INP(22) + layer * LW;
    const float* ba = INP(24) + layer * LW; const float* bx = INP(26) + layer * LW; const float* lam = INP(27) + layer * LW;
    int lane_l = C.lane; asm volatile("" : "+v"(lane_l));
    const int lane = lane_l, r16 = lane & 15, g = lane >> 4, cidx = item >> 3, n = item & 7, m0 = cidx * 64; const bool seq0 = (cidx % NCH_SEQ) == 0;
    const lptr tHL = C.lds + C.wave * 16384, tAP = tHL + 8192;
#define LRU_FETCH(ntv, BA, BX, LM, WA, WX) do { const int co_ = 64 * n + 16 * (ntv) + r16; BA = ba[co_]; BX = bx[co_]; LM = lam[co_]; \
        _Pragma("unroll") for (int s_ = 0; s_ < 2; ++s_) { WA[s_] = gl_frag(LWA + (size_t)(n * 64 + 16 * (ntv) + r16) * 64 + 32 * s_ + 8 * g); WX[s_] = gl_frag(LWX + (size_t)(n * 64 + 16 * (ntv) + r16) * 64 + 32 * s_ + 8 * g); } } while (0)
    const int nt_lo = half < 0 ? 0 : 2 * half, nt_hi = half < 0 ? 4 : 2 * half + 2;
    float c_ba, c_bx, c_lm, n_ba = 0.f, n_bx = 0.f, n_lm = 0.f; bf16x8 c_wa[2], c_wx[2], n_wa[2], n_wx[2];
    LRU_FETCH(nt_lo, c_ba, c_bx, c_lm, c_wa, c_wx);
#pragma unroll
    for (int s_ = 0; s_ < 2; ++s_) { n_wa[s_] = c_wa[s_]; n_wx[s_] = c_wx[s_]; }
    { const unsigned traw = (unsigned)__builtin_amdgcn_readfirstlane((int)(unsigned)(size_t)tHL);
#pragma unroll
      for (int k = 0; k < 9; ++k) { const int rr = 8 * k + (lane >> 3); int tok = (rr > 66 ? 66 : rr) - 3; if (seq0 && tok < 0) tok = 0;
          glds16_asm(PL + (size_t)(m0 + tok) * 1024 + 64 * n + 8 * ((lane & 7) ^ (rr & 7)), traw + k * 1024); } }
    bf16x8 af[4][2];
    float w[2][4][8], cb8[2][8];
#pragma unroll
    for (int s = 0; s < 2; ++s) { const int chb = 64 * n + 32 * s + 8 * g;
#pragma unroll
        for (int jj = 0; jj < 4; ++jj) { const f32x4 w0 = *(const GAS f32x4*)(cw + jj * LW + chb), w1 = *(const GAS f32x4*)(cw + jj * LW + chb + 4);
#pragma unroll
            for (int e = 0; e < 4; ++e) { w[s][jj][e] = w0[e]; w[s][jj][4 + e] = w1[e]; } }
        { const f32x4 c0 = *(const GAS f32x4*)(cbias + chb), c1 = *(const GAS f32x4*)(cbias + chb + 4);
#pragma unroll
          for (int e = 0; e < 4; ++e) { cb8[s][e] = c0[e]; cb8[s][4 + e] = c1[e]; } } }
    asm volatile("s_waitcnt vmcnt(0)" ::: "memory");
#pragma unroll
    for (int s = 0; s < 2; ++s) {
#pragma unroll
        for (int mt = 0; mt < 4; ++mt) {
            float xb[8];
#pragma unroll
            for (int e = 0; e < 8; ++e) xb[e] = cb8[s][e];
#pragma unroll
            for (int jj = 0; jj < 4; ++jj) { const int rr = 16 * (r16 >> 2) + 4 * mt + (r16 & 3) + jj;
                v4u xv = *(const LAS v4u*)(tHL + rr * 128 + (((4 * s + g) ^ (rr & 7)) << 4));
                if (seq0 && rr < 3) xv = (v4u){0u, 0u, 0u, 0u};
                xb[0] += w[s][jj][0] * bflo(xv.x); xb[1] += w[s][jj][1] * bfhi(xv.x); xb[2] += w[s][jj][2] * bflo(xv.y); xb[3] += w[s][jj][3] * bfhi(xv.y);
                xb[4] += w[s][jj][4] * bflo(xv.z); xb[5] += w[s][jj][5] * bfhi(xv.z); xb[6] += w[s][jj][6] * bflo(xv.w); xb[7] += w[s][jj][7] * bfhi(xv.w); }
            const v4u pw = (v4u){pk2(xb[0], xb[1]), pk2(xb[2], xb[3]), pk2(xb[4], xb[5]), pk2(xb[6], xb[7])};
            af[mt][s] = __builtin_bit_cast(bf16x8, pw);
        }
    }
    LDS_WAIT(); asm volatile("" ::: "memory");
#pragma unroll 1
    for (int nt = nt_lo; nt < nt_hi; ++nt) {
        const int co = 64 * n + 16 * nt + r16;
        if (nt + 1 < nt_hi) LRU_FETCH(nt + 1, n_ba, n_bx, n_lm, n_wa, n_wx);
        const float bac = NL2E * c_ba, bxc = NL2E * c_bx, lm = c_lm;
        const float s8 = 8.0f * NL2E * (fmaxf(-lm, 0.f) + __logf(1.0f + __expf(-fabsf(lm))));
        f32x4 ga[4], gx[4], xi[4];
#pragma unroll
        for (int mt = 0; mt < 4; ++mt) { ga[mt] = (f32x4){bac, bac, bac, bac}; gx[mt] = (f32x4){bxc, bxc, bxc, bxc}; xi[mt] = (f32x4){0.f, 0.f, 0.f, 0.f}; }
#pragma unroll
        for (int s = 0; s < 2; ++s) {
            const bf16x8 wa = c_wa[s], wx = c_wx[s];
            bf16x8 idf;
#pragma unroll
            for (int j = 0; j < 8; ++j) idf[j] = (32 * s + 8 * g + j == 16 * nt + r16) ? (short)0x3F80 : (short)0;
#pragma unroll
            for (int mt = 0; mt < 4; ++mt) { ga[mt] = mfma16(af[mt][s], wa, ga[mt]); gx[mt] = mfma16(af[mt][s], wx, gx[mt]); xi[mt] = mfma16(af[mt][s], idf, xi[mt]); }
        }
        const int up16 = lane >= 16 ? lane - 16 : lane, up32 = lane >= 32 ? lane - 32 : lane;
        float Ai[4][4], Bi[4][4]; float ra = 1.f, rb = 0.f;
#pragma unroll
        for (int mt = 0; mt < 4; ++mt)
#pragma unroll
            for (int i = 0; i < 4; ++i) {
                const float gav = __builtin_amdgcn_rcpf(1.0f + __builtin_amdgcn_exp2f(ga[mt][i])), gxv = __builtin_amdgcn_rcpf(1.0f + __builtin_amdgcn_exp2f(gx[mt][i]));
                const float a = __builtin_amdgcn_exp2f(s8 * gav);
                float mult = __builtin_amdgcn_sqrtf(fmaxf(1.0f - a * a, 0.f)); if (seq0 && mt == 0 && i == 0 && g == 0) mult = 1.0f;
                const float bb = xi[mt][i] * gxv * mult;
                rb = a * rb + bb; ra = ra * a; Ai[mt][i] = ra; Bi[mt][i] = rb;
            }
        float IA = ra, IB = rb;
        { const float pA = bperm(IA, up16), pB = bperm(IB, up16); if (g >= 1) { IB = IA * pB + IB; IA = pA * IA; } }
        { const float pA = bperm(IA, up32), pB = bperm(IB, up32); if (g >= 2) { IB = IA * pB + IB; IA = pA * IA; } }
        float EA = bperm(IA, up16), EB = bperm(IB, up16); if (g == 0) { EA = 1.f; EB = 0.f; }
        const float cA = bperm(IA, 48 + r16), cB = bperm(IB, 48 + r16);
#pragma unroll
        for (int mt = 0; mt < 4; ++mt)
#pragma unroll
            for (int i = 0; i < 4; ++i) { lds_st16(tHL, 16 * g + 4 * mt + i, 16 * nt + r16, Ai[mt][i] * EB + Bi[mt][i]); lds_st16(tAP, 16 * g + 4 * mt + i, 16 * nt + r16, Ai[mt][i] * EA); }
        if (g == 0) { AGG[((size_t)cidx * LW + co) * 2] = cA; AGG[((size_t)cidx * LW + co) * 2 + 1] = cB; }
        c_ba = n_ba; c_bx = n_bx; c_lm = n_lm;
#pragma unroll
        for (int s_ = 0; s_ < 2; ++s_) { c_wa[s_] = n_wa[s_]; c_wx[s_] = n_wx[s_]; }
    }
#undef LRU_FETCH
    LDS_WAIT(); asm volatile("" ::: "memory");
    if (half < 0) { const int ts = lane >> 3, cg8 = (lane & 7) * 8;
#pragma unroll
      for (int it = 0; it < 8; ++it) { const int t = 8 * it + ts; const size_t go = (size_t)(m0 + t) * LW + 64 * n + cg8;
          *(GAS v4u*)(HL + go) = *(const LAS v4u*)(tHL + sw_off(t, cg8)); *(GAS v4u*)(AP + go) = *(const LAS v4u*)(tAP + sw_off(t, cg8)); } }
    else { const int ts = lane >> 2, cg8 = 32 * half + (lane & 3) * 8;
#pragma unroll
      for (int it = 0; it < 4; ++it) { const int t = 16 * it + ts; const size_t go = (size_t)(m0 + t) * LW + 64 * n + cg8;
          *(GAS v4u*)(HL + go) = *(const LAS v4u*)(tHL + sw_off(t, cg8)); *(GAS v4u*)(AP + go) = *(const LAS v4u*)(tAP + sw_off(t, cg8)); } }
    LDS_WAIT(); asm volatile("" ::: "memory");
}
__device__ __forceinline__ float gelu_tanh(float x) { const float u = 0.7978845608028654f * (x + 0.044715f * x * x * x); return 0.5f * x * (1.0f + tanh_fast(u)); }
__device__ __forceinline__ void lru_carry_wave(const Ctx& C, int layer, int item) {
    const bf16* PL = (const bf16*)(C.ws + WS_PL); const bf16* HL = (const bf16*)(C.ws + WS_HL); const bf16* AP = (const bf16*)(C.ws + WS_AP); const float* AGG = (const float*)(C.ws + WS_AGG); bf16* OB = (bf16*)(C.ws + WS_OB);
    int lane_l = C.lane; asm volatile("" : "+v"(lane_l));
    const int lane = lane_l, cidx = item >> 3, n = item & 7, ch = 64 * n + lane, m0 = cidx * 64, cs = cidx % NCH_SEQ, c_first = cidx - cs;
    float hin = 0.f;
    { const float* ag0 = AGG + ((size_t)c_first * LW + ch) * 2; int j = 0;
      for (; j + 16 <= cs; j += 16) { v2u ab[16];
#pragma unroll
          for (int e = 0; e < 16; ++e) ab[e] = *(const GAS v2u*)(ag0 + (size_t)(j + e) * LW * 2);
#pragma unroll
          for (int e = 0; e < 16; ++e) hin = __uint_as_float(ab[e].x) * hin + __uint_as_float(ab[e].y); }
      if (j < cs) { v2u ab[16];
#pragma unroll
          for (int e = 0; e < 16; ++e) { const int je = j + e < cs ? j + e : cs - 1; ab[e] = *(const GAS v2u*)(ag0 + (size_t)je * LW * 2); }
#pragma unroll
          for (int e = 0; e < 16; ++e) { const bool ok = j + e < cs; const float a_ = ok ? __uint_as_float(ab[e].x) : 1.0f, b_ = ok ? __uint_as_float(ab[e].y) : 0.0f; hin = a_ * hin + b_; } } }
    LAS float* hb = (LAS float*)(C.lds + C.wave * 16384);
    hb[lane] = hin; LDS_WAIT(); asm volatile("" ::: "memory");
    const int ts = lane >> 3, cg8 = (lane & 7) * 8;
    float h8[8];
#pragma unroll
    for (int e = 0; e < 8; ++e) h8[e] = hb[cg8 + e];
    LDS_WAIT(); asm volatile("" ::: "memory");
    v4u hq[8], aq[8], gq8[8];
#pragma unroll
    for (int it = 0; it < 8; ++it) { const int t = 8 * it + ts; const size_t go = (size_t)(m0 + t) * LW + 64 * n + cg8;
        hq[it] = *(const GAS v4u*)(HL + go); aq[it] = *(const GAS v4u*)(AP + go); gq8[it] = *(const GAS v4u*)(PL + (size_t)(m0 + t) * 1024 + LW + 64 * n + cg8); }
#pragma unroll
    for (int it = 0; it < 8; ++it) { const int t = 8 * it + ts;
        const v4u hv = hq[it], av = aq[it], gv = gq8[it];
        const unsigned hw[4] = {hv.x, hv.y, hv.z, hv.w}, aw[4] = {av.x, av.y, av.z, av.w}, gw_[4] = {gv.x, gv.y, gv.z, gv.w}; unsigned ow[4];
#pragma unroll
        for (int q = 0; q < 4; ++q) { const float o0 = (bflo(hw[q]) + bflo(aw[q]) * h8[2 * q]) * gelu_tanh(bflo(gw_[q])), o1 = (bfhi(hw[q]) + bfhi(aw[q]) * h8[2 * q + 1]) * gelu_tanh(bfhi(gw_[q])); ow[q] = pk2(o0, o1); }
        *(GAS v4u*)((GAS char*)OB + pg8::img_byte(m0 + t, 64 * n + cg8, LW)) = (v4u){ow[0], ow[1], ow[2], ow[3]}; }
}
struct Args { const float* in[31]; float* out; unsigned char* ws; int ph_lo, ph_hi; };
#ifndef MK_SP2
#define MK_SP2 true
#endif
__global__ void __launch_bounds__(NWAVES * 64, 2) hybrid_fwd(Args args) {
    extern __shared__ __attribute__((aligned(16))) unsigned char lds_raw[];
    const lptr ldsb = (lptr)lds_raw; const int tid0 = threadIdx.x;
    constexpr int G = GRID; int vcu; { const int bx = blockIdx.x; vcu = (G % 8 == 0) ? (bx % 8) * (G / 8) + bx / 8 : bx; }
    volatile LAS unsigned* MISC = (volatile LAS unsigned*)(ldsb + MISC_OFF);
    for (int u = tid0; u < (LDS_BYTES - MISC_OFF) / 4; u += NWAVES * 64) MISC[u] = 0u;
    __syncthreads();
    if (tid0 < 31) *(LAS unsigned long long*)(ldsb + TAB_OFF + 8 * tid0) = (unsigned long long)args.in[tid0];
    __syncthreads();
    XcdBarrier bar; bar.bar = (unsigned*)(args.ws + WS_CTL) + CW_BAR; bar.x = 0; bar.st = nullptr;
    const int lo = args.ph_lo, hi = args.ph_hi;
    if (hi - lo > 1) { bar = xcd_barrier_post((unsigned*)(args.ws + WS_CTL) + CW_BAR, MISC + 8); xcd_local_census_post(bar); }

    for (int p = lo; p < hi; ++p) {
        int tidp = threadIdx.x; asm volatile("" : "+v"(tidp));
        Ctx C; C.lds = ldsb; C.tid = tidp; C.lane = tidp & 63; C.wave = __builtin_amdgcn_readfirstlane(tidp >> 6); C.vcu = vcu; C.G = G; C.ws = args.ws; C.out = args.out;
        int bxp = blockIdx.x; asm volatile("" : "+s"(bxp));
        const int gw = C.vcu * NWAVES + C.wave, NGW = C.G * NWAVES;
        bf16* XN = (bf16*)(C.ws + WS_XN);
        const int layer = p / PH_PER_LAYER, k = p % PH_PER_LAYER;
        if ((k == 0 && layer > 0) || k == 3 || k == 10 || k == 13) continue;
        if (k == 0) {
            if (layer == 0) {
                { unsigned long long* xs = (unsigned long long*)(C.ws + WS_XS);
                  for (int i = C.vcu * (NWAVES * 64) + C.tid; i < (int)(12 * XS_BYTES / 8); i += C.G * NWAVES * 64) __hip_atomic_store(xs + i, 0ull, __ATOMIC_RELAXED, __HIP_MEMORY_SCOPE_AGENT); }
                conv_ffn(C, 0, 0, gw, NGW); norm_phase(C, INP(0), INP(1), XN); }
        } else if ((k == 1 || k == 11)) {
            pg8::Gemm gm{XN, (const bf16*)(C.ws + ffn_w_off(layer, k == 1 ? 0 : 1)), M, NUP, D}; pg8::StaticOrder S; S.init(M, NUP, C.G, bxp);
            pg8::EpiSwiglu E{(bf16*)(C.ws + WS_H), FF};
            pg8::gemm_phase<pg8::EpiSwiglu, pg8::StaticOrder, true, MK_SP2>(C.lds, gm, S, E);
            { pg8::Unit t6; if (!S.next(5, t6)) { const int nidle = (6 * GRID - (M / 256) * (NUP / 256)), hw = (bxp - (GRID - nidle)) * NWAVES + C.wave;
                if (k == 1) conv_mix(C, layer, hw, nidle * NWAVES); else if (layer == 0) conv_ffn(C, 1, 0, hw, nidle * NWAVES); } }
        } else if ((k == 2 || k == 9 || k == 12)) {
            const int site = (k == 2) ? 0 : (k == 9 ? 1 : 2), gi = 2 * site + 1, ex = (layer * 3 + site) * 2;
            const float* ng = INP(1) + (size_t)layer * 6 * D;
            const bool last = (layer == 1 && k == 12);
            const float* gpre = (k == 12) ? (INP(1) + (size_t)(layer + 1) * 6 * D) : ng + (gi + 1) * D;
            pg8::Gemm gm = (k == 9) ? pg8::Gemm{(const bf16*)(C.ws + WS_Y), (const bf16*)(C.ws + WS_WOT), M, D, D} : pg8::Gemm{(const bf16*)(C.ws + WS_H), (const bf16*)(C.ws + ffn_w_off(layer, k == 2 ? 0 : 1)) + (size_t)NUP * D, M, D, FF};
            pg8::StaticOrder S; S.init(M, D, C.G, bxp);
            unsigned* tmo = (unsigned*)(C.ws + WS_CTL);
            pg8::RmsStats st1{(unsigned long long*)(C.ws + WS_XS + (size_t)ex * XS_BYTES), tmo, RMS_EPS};
            pg8::RmsStats st2{(unsigned long long*)(C.ws + WS_XS + (size_t)(ex + 1) * XS_BYTES), tmo, RMS_EPS};
            const int sidx = layer * 3 + site;
            const float* rsi_in = (const float*)(C.ws + WS_RSI) + (size_t)(sidx & 1) * M; float* rsi_out = (float*)(C.ws + WS_RSI) + (size_t)((sidx + 1) & 1) * M;
            if (!last) { pg8::EpiRmsRes<true> E{XN, rsi_in, rsi_out, C.out, D, ng + (gi - 1) * D, ng + gi * D, (k == 9) ? 1.0f : 0.5f, gpre, st1, st2};
                pg8::gemm_phase<pg8::EpiRmsRes<true>, pg8::StaticOrder, false, MK_SP2>(C.lds, gm, S, E); }
            else { pg8::EpiRmsRes<false> E{XN, rsi_in, rsi_out, C.out, D, ng + (gi - 1) * D, ng + gi * D, 0.5f, nullptr, st1, st2};
                pg8::gemm_phase<pg8::EpiRmsRes<false>, pg8::StaticOrder, false, MK_SP2>(C.lds, gm, S, E); }
        } else if (k == 4) {
            pg8::Gemm gm{XN, (const bf16*)(C.ws + WS_WIN), M, NAL, D}; pg8::StaticOrder S; S.init(M, NAL, C.G, bxp);
            pg8::EpiMap<0> E{(bf16*)(C.ws + WS_PA), WSH, WSH / 256, (bf16*)(C.ws + WS_PL), 1024};
            pg8::gemm_phase<pg8::EpiMap<0>, pg8::StaticOrder, true, MK_SP2>(C.lds, gm, S, E);
            { pg8::Unit t3; if (!S.next(2, t3)) { const int nidle = 3 * GRID - (M / 256) * (NAL / 256), hw = (bxp - (GRID - nidle)) * NWAVES + C.wave; conv_ffn(C, layer, 1, hw, nidle * NWAVES); } }
        } else if (k == 5) {
            prepA_phase(C, layer);
        } else if (k == 6) {
            const int xcd = C.vcu >> 5, slot = C.vcu & 31;
            if (slot < 8) { const int bh = ((slot >> 2) << 3) | xcd, vs = slot & 3;
                if (C.wave == 0) stageB_consumer(C, layer, bh, vs); else if (C.wave <= SB_NLD) stageB_loader(C, layer, bh, vs, C.wave - 1); }
            else { const int lw = xcd * 24 + slot - 8, hw = C.wave * (C.G - 64) + lw, NHW = (C.G - 64) * NWAVES;
                for (int it = hw; it < NCHUNK * 8; it += NHW) lru_tile_wave(C, layer, it, -1);
                }
        } else if (k == 7) {
            for (int it = gw; it < NCHUNK * NH; it += NGW) stageC_wave(C, layer, it);
            for (int it = gw; it < NCHUNK * 8; it += NGW) lru_carry_wave(C, layer, it);
        } else if (k == 8) {
            pg8::StaticOrder S; S.init(M, D, C.G, bxp); pg8::Unit base;
            for (int i = 0; S.next(i, base); ++i) {
                { pg8::Gemm gm{XN, (const bf16*)(C.ws + WS_WIN) + (size_t)NAL * D, M, NGT, D}; pg8::PairOrder PO{base};
                  pg8::EpiMap<1> E{(bf16*)(C.ws + WS_G), NGT, 1 << 20, (bf16*)(C.ws + WS_G), NGT};
                  pg8::gemm_phase<pg8::EpiMap<1>, pg8::PairOrder, true, MK_SP2>(C.lds, gm, PO, E); }
                { pg8::Gemm gm{(const bf16*)(C.ws + WS_OA), (const bf16*)(C.ws + WS_PAT), 2 * M, 2 * D, RW}; pg8::XPairOrder XO{base};
                  pg8::EpiGateMerge2 E{(bf16*)(C.ws + WS_Y), D, (const bf16*)(C.ws + WS_G), NGT};
                  pg8::gemm_phase<pg8::EpiGateMerge2, pg8::XPairOrder, true, MK_SP2>(C.lds, gm, XO, E); }
            }
        }
        if (p + 1 < hi && !(layer == 1 && k == 12)) {
            bool local = (k == 1 || k == 8 || k == 11);
            if (local) { unsigned lk = MISC[12]; if (lk == 0u) { __syncthreads(); if (tidp == 0) MISC[12] = xcd_local_ok(bar) ? 1u : 2u; __syncthreads(); lk = MISC[12]; } local = (lk == 1u); }
            if (local) xcd_barrier_local(bar); else xcd_barrier(bar);
        }

    }
}

#ifndef MK_ONE_LAUNCH
#define MK_ONE_LAUNCH 1
#endif
extern "C" void kernel_launch(void* const* d_in, const int* in_sizes, int n_in, void* d_out, int out_size, void* d_ws, size_t ws_size, hipStream_t stream) {
    static int grid = 0; static bool one_launch = true;
    if (grid == 0) {
        if (n_in != 31 || in_sizes[0] != M * D || out_size != M * D || ws_size < WS_END) { fprintf(stderr, "kernel_launch: unexpected problem (n_in %d, in0 %d, out %d, ws %zu); nothing launched\n", n_in, n_in > 0 ? in_sizes[0] : -1, out_size, ws_size); grid = -1; return; }
        int dev = 0, cus = 0;
        if (hipGetDevice(&dev) != hipSuccess || hipDeviceGetAttribute(&cus, hipDeviceAttributeMultiprocessorCount, dev) != hipSuccess) { grid = -1; return; }
        if (hipFuncSetAttribute((const void*)hybrid_fwd, hipFuncAttributeMaxDynamicSharedMemorySize, LDS_BYTES) != hipSuccess) { fprintf(stderr, "kernel_launch: hipFuncSetAttribute failed\n"); grid = -1; return; }
        (void)hipGetLastError();
        int occ = 0;
        if (hipOccupancyMaxActiveBlocksPerMultiprocessor(&occ, hybrid_fwd, NWAVES * 64, LDS_BYTES) != hipSuccess) occ = 0;
        (void)hipGetLastError();
        one_launch = (long long)occ * cus >= GRID;
        if (!one_launch) fprintf(stderr, "kernel_launch: %d CUs x %d workgroups cannot hold the %d-workgroup grid; falling back to one launch per phase\n", cus, occ, GRID);
        grid = GRID;
    }
    if (grid < 0) return;
    (void)hipMemsetAsync((char*)d_ws + WS_CTL, 0, CTL_ZERO_BYTES, stream);
    Args a{};
    for (int i = 0; i < 31; ++i) a.in[i] = (const float*)d_in[i];
    a.out = (float*)d_out; a.ws = (unsigned char*)d_ws;
    if (MK_ONE_LAUNCH && one_launch) {
        a.ph_lo = 0; a.ph_hi = N_PHASES;
        void* kargs[] = {&a};
        if (hipLaunchCooperativeKernel((const void*)hybrid_fwd, dim3(grid), dim3(NWAVES * 64), kargs, LDS_BYTES, stream) != hipSuccess) {
            (void)hipGetLastError();
            hipLaunchKernelGGL(hybrid_fwd, dim3(grid), dim3(NWAVES * 64), LDS_BYTES, stream, a);
        }
    } else {
        for (int p = 0; p < N_PHASES; ++p) {
            const int layer = p / PH_PER_LAYER, k = p % PH_PER_LAYER;
            if ((k == 0 && layer > 0) || k == 3 || k == 10 || k == 13) continue;
            a.ph_lo = p; a.ph_hi = p + 1;
            hipLaunchKernelGGL(hybrid_fwd, dim3(grid), dim3(NWAVES * 64), LDS_BYTES, stream, a);
        }
    }
}
```
